# Optimizing an MI355X kernel written in HIP

```python
import jax
import jax.numpy as jnp
from jax import lax
import numpy as np

D_MODEL = 1024
BATCH = 8
SEQ = 4096
DEPTH = 2

CHUNK = 64
Q_BLOCK = 128
HEAD_DIM = 64
NEG_INF = -1e30
LN_EPS = 1e-5
RMS_EPS = 1e-6

MLA_HEADS = 8
MLA_Q_RANK = 384
MLA_KV_RANK = 256
MLA_NOPE = 64
MLA_ROPE = 32
MLA_V = 64
ROPE_THETA = 10000.0

SWA_HEADS = 8
SWA_KV_HEADS = 2
SWA_WINDOW = 128
SWA_LEFT_CHUNKS = SWA_WINDOW // CHUNK

FOX_HEADS = 8

CK_HEADS = 8
CK_LEFT_CHUNKS = 8
REL_MAX = 256
REL_TABLE = REL_MAX + CHUNK

D_FF = -(-8 * D_MODEL // (3 * 256)) * 256

DEEPNORM_ALPHA = (2 * DEPTH) ** 0.25
DEEPNORM_BETA = (8 * DEPTH) ** -0.25

AB_SPLITS = (MLA_Q_RANK, MLA_KV_RANK, MLA_ROPE, SWA_HEADS * HEAD_DIM, SWA_KV_HEADS * HEAD_DIM, SWA_KV_HEADS * HEAD_DIM)
CD_SPLITS = (FOX_HEADS * HEAD_DIM,) * 3 + (FOX_HEADS,) + (CK_HEADS * HEAD_DIM,) * 3
AB_MIX = MLA_HEADS * MLA_V + SWA_HEADS * HEAD_DIM
CD_MIX = (FOX_HEADS + CK_HEADS) * HEAD_DIM

kernel_name = 'hybrid_chunk_causal_mla_swa_fox_relpos_deepnorm'


def _split_cols(x, widths):
    return jnp.split(x, [int(i) for i in np.cumsum(widths)[:-1]], axis=-1)


def _layer_norm(x, g, b):
    xf = x.astype(jnp.float32)
    mu = jnp.mean(xf, -1, keepdims=True)
    var = jnp.mean(jnp.square(xf - mu), -1, keepdims=True)
    y = (xf - mu) * lax.rsqrt(var + LN_EPS) * g.astype(jnp.float32) + b.astype(jnp.float32)
    return y.astype(x.dtype)


def _rms_norm(x, g):
    xf = x.astype(jnp.float32)
    y = xf * lax.rsqrt(jnp.mean(xf * xf, -1, keepdims=True) + RMS_EPS)
    return (y * g.astype(jnp.float32)).astype(x.dtype)


def _rope_tables(S):
    inv = ROPE_THETA ** (-jnp.arange(0, MLA_ROPE, 2, dtype=jnp.float32) / MLA_ROPE)
    ang = jnp.arange(S, dtype=jnp.float32)[:, None] * inv[None, :]
    return jnp.cos(ang), jnp.sin(ang)


def _apply_rope(x, cos, sin):
    x1, x2 = jnp.split(x.astype(jnp.float32), 2, axis=-1)
    return jnp.concatenate([x1 * cos - x2 * sin, x1 * sin + x2 * cos], -1).astype(x.dtype)


def _alibi_slopes(n):
    return jnp.exp2(-8.0 * jnp.arange(1, n + 1, dtype=jnp.float32) / n)


def _sweep_query_blocks(block_fn, *q_parts):
    B, S = q_parts[0].shape[:2]
    nb = S // Q_BLOCK
    blocked = tuple(jnp.moveaxis(p.reshape(B, nb, Q_BLOCK, *p.shape[2:]), 1, 0) for p in q_parts)
    out = lax.map(lambda a: block_fn(a[0], *a[1]), (jnp.arange(nb), blocked))
    return jnp.moveaxis(out, 0, 1).reshape(B, S, *out.shape[3:])


def _band(x, n_left):
    B, S = x.shape[:2]
    nc = S // CHUNK
    pad = [(0, 0), (n_left * CHUNK, 0)] + [(0, 0)] * (x.ndim - 2)
    xp = jnp.pad(x, pad).reshape(B, nc + n_left, CHUNK, *x.shape[2:])
    return jnp.concatenate([xp[:, j:j + nc] for j in range(n_left + 1)], axis=2)


def _band_geometry(nc, n_left):
    band = jnp.arange((n_left + 1) * CHUNK)
    key_off = band // CHUNK - n_left
    dist = jnp.arange(CHUNK)[:, None] - (key_off * CHUNK + band % CHUNK)[None, :]
    valid = (jnp.arange(nc)[:, None] + key_off[None, :]) >= 0
    return dist, valid


def _mla_attention(q_nope, q_rope, k_nope, k_rope, v):
    S = k_nope.shape[1]
    scale = (MLA_NOPE + MLA_ROPE) ** -0.5
    key_chunk = jnp.arange(S) // CHUNK

    def block(i, qn, qr):
        q_chunk = (i * Q_BLOCK + jnp.arange(Q_BLOCK)) // CHUNK
        logits = (jnp.einsum('bqhd,bkhd->bhqk', qn, k_nope, preferred_element_type=jnp.float32)
                  + jnp.einsum('bqhr,bkr->bhqk', qr, k_rope, preferred_element_type=jnp.float32)) * scale
        logits = jnp.where(key_chunk[None, :] <= q_chunk[:, None], logits, NEG_INF)
        p = jax.nn.softmax(logits, axis=-1).astype(v.dtype)
        return jnp.einsum('bhqk,bkhd->bqhd', p, v)

    return _sweep_query_blocks(block, q_nope, q_rope)


def _swa_sink_attention(q, k, v, sinks):
    B, S, _, d = q.shape
    nc = S // CHUNK
    G = SWA_HEADS // SWA_KV_HEADS
    qc = q.reshape(B, nc, CHUNK, SWA_KV_HEADS, G, d)
    kb, vb = _band(k, SWA_LEFT_CHUNKS), _band(v, SWA_LEFT_CHUNKS)
    dist, valid = _band_geometry(nc, SWA_LEFT_CHUNKS)
    alibi = -_alibi_slopes(SWA_HEADS).reshape(SWA_KV_HEADS, G, 1, 1) * jnp.abs(dist).astype(jnp.float32)
    logits = jnp.einsum('bcqkgd,bcskd->bckgqs', qc, kb, preferred_element_type=jnp.float32) * d ** -0.5 + alibi
    logits = jnp.where(valid[None, :, None, None, None, :], logits, NEG_INF)
    sink = jnp.broadcast_to(sinks.astype(jnp.float32).reshape(SWA_KV_HEADS, G, 1, 1), logits.shape[:-1] + (1,))
    p = jax.nn.softmax(jnp.concatenate([logits, sink], -1), axis=-1)[..., :-1].astype(v.dtype)
    return jnp.einsum('bckgqs,bcskd->bcqkgd', p, vb).reshape(B, S, SWA_HEADS, d)


def _forgetting_attention(q, k, v, f_logit, b_forget):
    S = k.shape[1]
    scale = q.shape[-1] ** -0.5
    cum_log_f = jnp.cumsum(jax.nn.log_sigmoid(f_logit.astype(jnp.float32) + b_forget.astype(jnp.float32)), axis=1)
    cum_k = jnp.swapaxes(cum_log_f, 1, 2)[:, :, None, :]
    key_pos = jnp.arange(S)

    def block(i, qb, cum_q):
        q_pos = i * Q_BLOCK + jnp.arange(Q_BLOCK)
        decay = jnp.swapaxes(cum_q, 1, 2)[..., None] - cum_k
        logits = jnp.einsum('bqhd,bkhd->bhqk', qb, k, preferred_element_type=jnp.float32) * scale + decay
        logits = jnp.where(key_pos[None, :] <= q_pos[:, None], logits, NEG_INF)
        p = jax.nn.softmax(logits, axis=-1).astype(v.dtype)
        return jnp.einsum('bhqk,bkhd->bqhd', p, v)

    return _sweep_query_blocks(block, q, cum_log_f)


def _chunk_relpos_attention(q, k, v, rel_bias):
    B, S, H, d = q.shape
    nc = S // CHUNK
    qc = q.reshape(B, nc, CHUNK, H, d)
    kb, vb = _band(k, CK_LEFT_CHUNKS), _band(v, CK_LEFT_CHUNKS)
    dist, valid = _band_geometry(nc, CK_LEFT_CHUNKS)
    idx = jnp.clip(dist, -(CHUNK - 1), REL_MAX) + (CHUNK - 1)
    bias = jnp.moveaxis(rel_bias[idx], -1, 0).astype(jnp.float32)
    logits = jnp.einsum('bcqhd,bcshd->bchqs', qc, kb, preferred_element_type=jnp.float32) * d ** -0.5 + bias
    logits = jnp.where(valid[None, :, None, None, :], logits, NEG_INF)
    p = jax.nn.softmax(logits, axis=-1).astype(v.dtype)
    return jnp.einsum('bchqs,bcshd->bcqhd', p, vb).reshape(B, S, H, d)


def _mixer_ab(h, w_in, q_norm, w_uq, kv_norm, w_ukv, sinks, w_out, cos, sin):
    B, S, _ = h.shape
    proj = jnp.einsum('bsd,df->bsf', h, w_in)
    c_q, c_kv, k_r, q_s, k_s, v_s = _split_cols(proj, AB_SPLITS)
    q = jnp.einsum('bsr,rf->bsf', _rms_norm(c_q, q_norm), w_uq).reshape(B, S, MLA_HEADS, MLA_NOPE + MLA_ROPE)
    q_nope = q[..., :MLA_NOPE]
    q_rope = _apply_rope(q[..., MLA_NOPE:], cos[None, :, None], sin[None, :, None])
    kv = jnp.einsum('bsr,rf->bsf', _rms_norm(c_kv, kv_norm), w_ukv).reshape(B, S, MLA_HEADS, MLA_NOPE + MLA_V)
    k_rope = _apply_rope(k_r, cos[None], sin[None])
    o_a = _mla_attention(q_nope, q_rope, kv[..., :MLA_NOPE], k_rope, kv[..., MLA_NOPE:])
    o_b = _swa_sink_attention(q_s.reshape(B, S, SWA_HEADS, HEAD_DIM),
                              k_s.reshape(B, S, SWA_KV_HEADS, HEAD_DIM),
                              v_s.reshape(B, S, SWA_KV_HEADS, HEAD_DIM), sinks)
    o = jnp.concatenate([o_a.reshape(B, S, -1), o_b.reshape(B, S, -1)], -1)
    return jnp.einsum('bsf,fd->bsd', o, w_out)


def _mixer_cd(h, w_in, b_forget, rel_bias, w_out):
    B, S, _ = h.shape
    proj = jnp.einsum('bsd,df->bsf', h, w_in)
    q_f, k_f, v_f, f_logit, q_c, k_c, v_c = _split_cols(proj, CD_SPLITS)
    o_c = _forgetting_attention(q_f.reshape(B, S, FOX_HEADS, HEAD_DIM), k_f.reshape(B, S, FOX_HEADS, HEAD_DIM),
                                v_f.reshape(B, S, FOX_HEADS, HEAD_DIM), f_logit, b_forget)
    o_d = _chunk_relpos_attention(q_c.reshape(B, S, CK_HEADS, HEAD_DIM), k_c.reshape(B, S, CK_HEADS, HEAD_DIM),
                                  v_c.reshape(B, S, CK_HEADS, HEAD_DIM), rel_bias)
    o = jnp.concatenate([o_c.reshape(B, S, -1), o_d.reshape(B, S, -1)], -1)
    return jnp.einsum('bsf,fd->bsd', o, w_out)


def _swiglu(x, w_gate, w_up, w_down):
    g = jnp.einsum('bsd,df->bsf', x, w_gate)
    u = jnp.einsum('bsd,df->bsf', x, w_up)
    return jnp.einsum('bsf,fd->bsd', jax.nn.silu(g) * u, w_down)


def setup_inputs(seed: int = 0) -> dict:
    key = jax.random.key(seed)
    ks = jax.random.split(key, 20)
    ne, no = (DEPTH + 1) // 2, DEPTH // 2
    f32 = jnp.float32

    def normal(k, shape, scale):
        return jax.random.normal(k, shape, f32) * scale

    def gain(k, shape):
        return 1.0 + normal(k, shape, 0.02)

    return {
        'x': normal(ks[0], (BATCH, SEQ, D_MODEL), 1.0),
        'ab_w_in': normal(ks[1], (ne, D_MODEL, sum(AB_SPLITS)), D_MODEL ** -0.5),
        'ab_q_norm': gain(ks[2], (ne, MLA_Q_RANK)),
        'ab_w_uq': normal(ks[3], (ne, MLA_Q_RANK, MLA_HEADS * (MLA_NOPE + MLA_ROPE)), MLA_Q_RANK ** -0.5),
        'ab_kv_norm': gain(ks[4], (ne, MLA_KV_RANK)),
        'ab_w_ukv': normal(ks[5], (ne, MLA_KV_RANK, MLA_HEADS * (MLA_NOPE + MLA_V)), MLA_KV_RANK ** -0.5),
        'ab_sinks': normal(ks[6], (ne, SWA_HEADS), 0.5),
        'ab_w_out': normal(ks[7], (ne, AB_MIX, D_MODEL), DEEPNORM_BETA * AB_MIX ** -0.5),
        'cd_w_in': normal(ks[8], (no, D_MODEL, sum(CD_SPLITS)), D_MODEL ** -0.5),
        'cd_b_forget': jax.random.uniform(ks[9], (no, FOX_HEADS), dtype=f32, minval=1.0, maxval=5.0),
        'cd_rel_bias': normal(ks[10], (no, REL_TABLE, CK_HEADS), 0.2),
        'cd_w_out': normal(ks[11], (no, CD_MIX, D_MODEL), DEEPNORM_BETA * CD_MIX ** -0.5),
        'ln1_g': gain(ks[12], (DEPTH, D_MODEL)),
        'ln1_b': normal(ks[13], (DEPTH, D_MODEL), 0.02),
        'ffn_w_gate': normal(ks[14], (DEPTH, D_MODEL, D_FF), D_MODEL ** -0.5),
        'ffn_w_up': normal(ks[15], (DEPTH, D_MODEL, D_FF), D_MODEL ** -0.5),
        'ffn_w_down': normal(ks[16], (DEPTH, D_FF, D_MODEL), DEEPNORM_BETA * D_FF ** -0.5),
        'ln2_g': gain(ks[17], (DEPTH, D_MODEL)),
        'ln2_b': normal(ks[18], (DEPTH, D_MODEL), 0.02),
    }


def reference(x, ab_w_in, ab_q_norm, ab_w_uq, ab_kv_norm, ab_w_ukv, ab_sinks, ab_w_out,
              cd_w_in, cd_b_forget, cd_rel_bias, cd_w_out,
              ln1_g, ln1_b, ffn_w_gate, ffn_w_up, ffn_w_down, ln2_g, ln2_b):
    cos, sin = _rope_tables(x.shape[1])
    for layer in range(DEPTH):
        i = layer // 2
        if layer % 2 == 0:
            mix = _mixer_ab(x, ab_w_in[i], ab_q_norm[i], ab_w_uq[i], ab_kv_norm[i], ab_w_ukv[i],
                            ab_sinks[i], ab_w_out[i], cos, sin)
        else:
            mix = _mixer_cd(x, cd_w_in[i], cd_b_forget[i], cd_rel_bias[i], cd_w_out[i])
        x = _layer_norm(DEEPNORM_ALPHA * x + mix, ln1_g[layer], ln1_b[layer])
        ffn = _swiglu(x, ffn_w_gate[layer], ffn_w_up[layer], ffn_w_down[layer])
        x = _layer_norm(DEEPNORM_ALPHA * x + ffn, ln2_g[layer], ln2_b[layer])
    return x
```

```cpp
#include <hip/hip_runtime.h>
#include <hip/hip_cooperative_groups.h>
#include <cstdio>
#include <cstdint>
#include <cstring>
namespace cg = cooperative_groups;

#ifndef ONE_LAUNCH
#define ONE_LAUNCH 1
#endif

#ifndef PROBE_REP
#define PROBE_REP -1
#endif
#define LAS __attribute__((address_space(3)))
typedef unsigned short bf16_t;
typedef short bf16x8 __attribute__((ext_vector_type(8)));
typedef short s16x4 __attribute__((ext_vector_type(4)));
typedef float f32x4 __attribute__((ext_vector_type(4)));
typedef float f32x16 __attribute__((ext_vector_type(16)));
typedef unsigned u32x4 __attribute__((ext_vector_type(4)));
typedef unsigned u32x2 __attribute__((ext_vector_type(2)));
typedef float f32x2_t __attribute__((ext_vector_type(2)));
typedef long i64x2 __attribute__((ext_vector_type(2)));

constexpr int BATCH = 8, SEQ = 4096, DM = 1024, MTOK = BATCH * SEQ;
constexpr int N0 = 1536;
constexpr int N1 = 3072;
constexpr int DFF = 2816;
constexpr float LN_EPS = 1e-5f, RMS_EPS = 1e-6f;
constexpr float ALPHA = 1.41421356237309515f;
constexpr float LOG2E = 1.4426950408889634f;

constexpr size_t MiB = 1u << 20;
constexpr size_t WS_CTL = 0, WS_BAR = 65536, CTL_ZERO_BYTES = 131072;
constexpr size_t WS_ROPE = 1 * MiB;
constexpr size_t WS_WIN0 = 2 * MiB, WS_WUQ = 5 * MiB, WS_WUKV = 6 * MiB, WS_WOUT0 = 7 * MiB, WS_WIN1 = 9 * MiB, WS_WOUT1 = 16 * MiB;
constexpr size_t WS_WGU0 = 18 * MiB, WS_WDN0 = 29 * MiB, WS_WGU1 = 35 * MiB, WS_WDN1 = 46 * MiB;
constexpr size_t WS_RSQ = 52 * MiB, WS_RSKV = 52 * MiB + 512 * 1024, WS_KROPE = 53 * MiB, WS_FLOG = 55 * MiB, WS_CUM = 56 * MiB;
constexpr size_t WS_WF = 58 * MiB;
constexpr size_t WS_STATS = 57 * MiB;
constexpr size_t WS_XB = 64 * MiB;
constexpr size_t WS_BIG = 128 * MiB;
constexpr size_t WS_Q = WS_BIG + 96 * MiB, WS_KV = WS_BIG + 144 * MiB;
constexpr size_t WS_O = 384 * MiB, WS_END = 448 * MiB;

constexpr int LDS_BYTES = 147456, LDS_BARW = 147456 - 64;
constexpr int NPH = 18;

__device__ __forceinline__ unsigned cvt_pk_bf16(float lo, float hi) { unsigned r; asm("v_cvt_pk_bf16_f32 %0, %1, %2" : "=v"(r) : "v"(lo), "v"(hi)); return r; }
__device__ __forceinline__ float bf_lo(unsigned u) { return __uint_as_float(u << 16); }
__device__ __forceinline__ float bf_hi(unsigned u) { return __uint_as_float(u & 0xffff0000u); }
__device__ __forceinline__ int tid_l() { int t = threadIdx.x; asm volatile("" : "+v"(t)); return t; }
__device__ __forceinline__ float half_max(float v) { auto rr = __builtin_amdgcn_permlane32_swap(__float_as_uint(v), __float_as_uint(v), false, false); return fmaxf(__uint_as_float(rr[0]), __uint_as_float(rr[1])); }
__device__ __forceinline__ float half_sum(float v) { auto rr = __builtin_amdgcn_permlane32_swap(__float_as_uint(v), __float_as_uint(v), false, false); return __uint_as_float(rr[0]) + __uint_as_float(rr[1]); }
template <int CTRL> __device__ __forceinline__ float dpp_get(float v) { return __builtin_bit_cast(float, __builtin_amdgcn_update_dpp(0, __builtin_bit_cast(int, v), CTRL, 0xF, 0xF, false)); }
__device__ __forceinline__ float wave_sum(float v) {
    v += dpp_get<0xB1>(v);
    v += dpp_get<0x4E>(v);
    v += dpp_get<0x141>(v);
    v += dpp_get<0x140>(v);
    v += __shfl_xor(v, 16);
    return half_sum(v);
}

namespace pg8 {
constexpr int BM = 256, BK = 64, HALF = 128, HTB = HALF * BK * 2, STAGE_BYTES = 8 * HTB, NXCD = 8, WGM = 8;
__device__ __forceinline__ int lds_byte(int r, int c) { const int st = (r >> 4) * 2 + (c >> 5), rr = r & 15, cc = c & 31, ob = rr * 64 + cc * 2; return st * 1024 + (ob ^ (((ob >> 9) & 1) << 5)); }
__device__ __forceinline__ void stage_rc(int b, int& R, int& C) { const int st = b / 1024, sb = b % 1024, swz = sb ^ (((sb >> 9) & 1) << 5); R = (st >> 1) * 16 + swz / 64; C = (st & 1) * 32 + (swz % 64) / 2; }
__device__ __forceinline__ int perm32(int rho) { const int n = rho >> 4, i = rho & 15; return 8 * (i >> 2) + 4 * n + (i & 3); }

struct Unit { int pm, pn; };
struct Gemm { const bf16_t* A; const bf16_t* Bt; int M, N, K, lda, ldb; };

struct StaticOrder {
    int nM, nN, nwg, G, c;
    __device__ void init(int M, int N, int G_, int c_) { nM = M / BM; nN = N / BM; nwg = nM * nN; G = G_; c = c_; }
    __device__ bool next(int i, Unit& u) const {
        const long L = (long)i * G + c; if (L >= nwg) return false;
        int wgid = (int)L; { const int q = nwg / NXCD, r = nwg % NXCD, xcd = wgid % NXCD, off = wgid / NXCD; wgid = (xcd < r ? xcd * (q + 1) : r * (q + 1) + (xcd - r) * q) + off; }
        const int nig = WGM * nN, gid = wgid / nig, fm = gid * WGM, gsz = (nM - fm) < WGM ? (nM - fm) : WGM;
        u.pm = fm + ((wgid % nig) % gsz); u.pn = (wgid % nig) / gsz; return true;
    }
};

template <int MODE>
struct Epi {
    int mode;
    bf16_t* O; int ldc; const float* rowscale; float* F32; int f32tile;
    const float* res; float* out; const float* lnstats; const float* lng; const float* lnb;
    __device__ __forceinline__ void operator()(const f32x4 (&acc)[2][2][4][2], const Unit& u, int wr, int wc, int fr, int fq) const {
        const int row0 = u.pm * BM + wr * 64 + fr;
        if (MODE == 0 || MODE == 4) {
            int colt = u.pn * BM; bf16_t* Ob = O;
            if (f32tile > 0) { const int t = colt / f32tile; Ob += (size_t)t * MTOK * f32tile; colt -= t * f32tile; }
            const int col0 = colt + wc * 32 + 8 * fq;
            float scv[2][4];
#pragma unroll
            for (int ai = 0; ai < 2; ++ai)
#pragma unroll
                for (int m = 0; m < 4; ++m) scv[ai][m] = (MODE == 4) ? rowscale[row0 + ai * HALF + m * 16] : 1.f;
#pragma unroll
            for (int ai = 0; ai < 2; ++ai)
#pragma unroll
                for (int m = 0; m < 4; ++m) {
                    const int row = row0 + ai * HALF + m * 16;
                    const float sc = scv[ai][m];
                    bf16_t* rowp = Ob + (size_t)row * ldc + col0;
#pragma unroll
                    for (int bj = 0; bj < 2; ++bj) {
                        const f32x4 v0 = acc[ai][bj][m][0] * sc, v1 = acc[ai][bj][m][1] * sc;
                        u32x4 w; w.x = cvt_pk_bf16(v0[0], v0[1]); w.y = cvt_pk_bf16(v0[2], v0[3]); w.z = cvt_pk_bf16(v1[0], v1[1]); w.w = cvt_pk_bf16(v1[2], v1[3]);
                        *(u32x4*)(rowp + bj * HALF) = w;
                    }
                }
        } else if (MODE == 1) {
            const int col0 = u.pn * HALF + wc * 32 + 8 * fq;
#pragma unroll
            for (int ai = 0; ai < 2; ++ai)
#pragma unroll
                for (int m = 0; m < 4; ++m) {
                    const int row = row0 + ai * HALF + m * 16;
                    float hv[8];
#pragma unroll
                    for (int n = 0; n < 2; ++n)
#pragma unroll
                        for (int e = 0; e < 4; ++e) { const float g = acc[ai][0][m][n][e], up = acc[ai][1][m][n][e]; hv[n * 4 + e] = g * __builtin_amdgcn_rcpf(1.f + __builtin_amdgcn_exp2f(-g * LOG2E)) * up; }
                    u32x4 w; w.x = cvt_pk_bf16(hv[0], hv[1]); w.y = cvt_pk_bf16(hv[2], hv[3]); w.z = cvt_pk_bf16(hv[4], hv[5]); w.w = cvt_pk_bf16(hv[6], hv[7]);
                    *(u32x4*)(O + (size_t)row * DFF + col0) = w;
                }
        } else {
            const int col0 = u.pn * BM + wc * 32 + 8 * fq;
            f32x4 gq[2][2], bq[2][2];
#pragma unroll
            for (int bj = 0; bj < 2; ++bj)
#pragma unroll
                for (int n = 0; n < 2; ++n) { gq[bj][n] = (MODE == 3) ? *(const f32x4*)(lng + col0 + bj * HALF + 4 * n) : (f32x4){1.f, 1.f, 1.f, 1.f}; bq[bj][n] = (MODE == 3) ? *(const f32x4*)(lnb + col0 + bj * HALF + 4 * n) : (f32x4){0.f, 0.f, 0.f, 0.f}; }
#pragma unroll
            for (int ai = 0; ai < 2; ++ai)
#pragma unroll
                for (int m = 0; m < 4; ++m) {
                    const int row = row0 + ai * HALF + m * 16;
                    const size_t off = (size_t)row * DM + col0;
                    f32x2_t st = {0.f, 1.f}; if (MODE == 3) st = *(const f32x2_t*)(lnstats + 2 * (size_t)row);
                    f32x4 rv[2][2];
#pragma unroll
                    for (int bj = 0; bj < 2; ++bj)
#pragma unroll
                        for (int n = 0; n < 2; ++n) rv[bj][n] = *(const f32x4*)(res + off + bj * HALF + 4 * n);
#pragma unroll
                    for (int bj = 0; bj < 2; ++bj)
#pragma unroll
                        for (int n = 0; n < 2; ++n) {
                            f32x4 r = rv[bj][n];
                            if (MODE == 3) r = (r - st.x) * st.y * gq[bj][n] + bq[bj][n];
                            *(f32x4*)(out + off + bj * HALF + 4 * n) = r * ALPHA + acc[ai][bj][m][n];
                        }
                }
        }
    }
};

template <class EpiT>
__device__ __forceinline__ void gemm_phase(LAS unsigned char* lds, const Gemm g, const StaticOrder& S, const EpiT& E) {
    const int tid = tid_l(), wid = __builtin_amdgcn_readfirstlane(tid >> 6), lane = tid & 63, wr = wid >> 2, wc = wid & 3, fr = lane & 15, fq = lane >> 4;
    const int K = g.K, nt = K / BK;
    unsigned voffA[2], voffB[2];
#pragma unroll
    for (int i = 0; i < 2; ++i) { int R, C; stage_rc(tid * 16 + i * 8192, R, C); const int Rb = (R & ~31) + perm32(R & 31);
        voffA[i] = (unsigned)(R * g.lda + C) * 2u; voffB[i] = (unsigned)(Rb * g.ldb + C) * 2u; }
    const size_t kstep = (size_t)(BK * 2);
    const size_t hstepA = (size_t)HALF * g.lda * 2, hstepB = (size_t)HALF * g.ldb * 2;
    const size_t tstepA = 2 * hstepA, tstepB = 2 * hstepB;
    const unsigned ldsw = (unsigned)wid * 1024u;
    const int aoff = lds_byte(wr * 64 + fr, fq * 8), boff = lds_byte(wc * 32 + fr, fq * 8);
#define PG8_SA(b, h) (((b) * 2 + (h)) * HTB)
#define PG8_SB(b, h) ((4 + (b) * 2 + (h)) * HTB)
#define PG8_STAGE(bufoff, gbase, voff) do { _Pragma("unroll") for (int _i = 0; _i < 2; ++_i) \
        __builtin_amdgcn_global_load_lds((const unsigned*)((const char*)(gbase) + (voff)[_i]), (LAS unsigned*)(lds + (bufoff) + ldsw + _i * 8192), 16, 0, 0); } while (0)
#define PG8_LDA(dst, b, h) do { _Pragma("unroll") for (int m = 0; m < 4; ++m) _Pragma("unroll") for (int k = 0; k < 2; ++k) dst[m][k] = *(const LAS bf16x8*)(lds + PG8_SA(b, h) + aoff + m * 2048 + k * 1024); } while (0)
#define PG8_LDB(dst, b, h) do { _Pragma("unroll") for (int n = 0; n < 2; ++n) _Pragma("unroll") for (int k = 0; k < 2; ++k) dst[n][k] = *(const LAS bf16x8*)(lds + PG8_SB(b, h) + boff + n * 2048 + k * 1024); } while (0)
#define PG8_MMA(ai, bj, At, Bt) do { __builtin_amdgcn_s_setprio(1); _Pragma("unroll") for (int m = 0; m < 4; ++m) _Pragma("unroll") for (int n = 0; n < 2; ++n) _Pragma("unroll") for (int k = 0; k < 2; ++k) \
        acc[ai][bj][m][n] = __builtin_amdgcn_mfma_f32_16x16x32_bf16(Bt[n][k], At[m][k], acc[ai][bj][m][n], 0, 0, 0); __builtin_amdgcn_s_setprio(0); } while (0)
#define PG8_WAIT_V(n) asm volatile("s_waitcnt vmcnt(" #n ")" ::: "memory")
#define PG8_WAIT_L(n) asm volatile("s_waitcnt lgkmcnt(" #n ")" ::: "memory")
#define PG8_BAR __builtin_amdgcn_s_barrier()
#define PG8_SCHED __builtin_amdgcn_sched_barrier(0)
    Unit cur, nxt; int ui = 0;
    if (!S.next(0, cur)) return;
    f32x4 acc[2][2][4][2];
#pragma unroll
    for (int a = 0; a < 2; ++a)
#pragma unroll
        for (int b = 0; b < 2; ++b)
#pragma unroll
            for (int m = 0; m < 4; ++m)
#pragma unroll
                for (int n = 0; n < 2; ++n) acc[a][b][m][n] = (f32x4){0.f, 0.f, 0.f, 0.f};
    bf16x8 At[4][2], B0[2][2], B1[2][2];
    const char* cA = (const char*)g.A + (size_t)cur.pm * tstepA; const char* cB = (const char*)g.Bt + (size_t)cur.pn * tstepB;
    PG8_STAGE(PG8_SB(0, 0), cB, voffB); PG8_STAGE(PG8_SB(0, 1), cB + hstepB, voffB); PG8_STAGE(PG8_SA(0, 0), cA, voffA); PG8_STAGE(PG8_SA(0, 1), cA + hstepA, voffA);
    if (wr == 1) PG8_BAR;
    PG8_WAIT_V(2); PG8_BAR;
    PG8_STAGE(PG8_SB(1, 0), cB + kstep, voffB); PG8_STAGE(PG8_SA(1, 0), cA + kstep, voffA); PG8_STAGE(PG8_SB(1, 1), cB + hstepB + kstep, voffB);
    PG8_WAIT_V(6); PG8_BAR;
    for (;;) {
        const bool has_next = S.next(ui + 1, nxt);
        const char* nA = has_next ? (const char*)g.A + (size_t)nxt.pm * tstepA : cA; const char* nB = has_next ? (const char*)g.Bt + (size_t)nxt.pn * tstepB : cB;
        for (int t = 0; t < nt; t += 2) {
            const bool last = (t == nt - 2);
            const char* a1 = cA + (size_t)(t + 1) * kstep;
            const char* a2 = last ? nA : cA + (size_t)(t + 2) * kstep; const char* b2 = last ? nB : cB + (size_t)(t + 2) * kstep;
            const char* a3 = a2 + kstep; const char* b3 = b2 + kstep;
            PG8_LDB(B0, 0, 0); PG8_LDB(B1, 0, 1); PG8_SCHED; PG8_LDA(At, 0, 0); PG8_STAGE(PG8_SA(1, 1), a1 + hstepA, voffA);
            PG8_WAIT_V(8); PG8_WAIT_L(0); PG8_BAR; PG8_MMA(0, 0, At, B0); PG8_MMA(0, 1, At, B1); PG8_BAR; PG8_SCHED;
            PG8_LDA(At, 0, 1); PG8_STAGE(PG8_SB(0, 0), b2, voffB); PG8_STAGE(PG8_SB(0, 1), b2 + hstepB, voffB); PG8_STAGE(PG8_SA(0, 0), a2, voffA);
            PG8_WAIT_V(8); PG8_WAIT_L(0); PG8_BAR; PG8_MMA(1, 0, At, B0); PG8_MMA(1, 1, At, B1); PG8_BAR; PG8_SCHED;
            PG8_LDB(B0, 1, 0); PG8_LDB(B1, 1, 1); PG8_SCHED; PG8_LDA(At, 1, 0); PG8_STAGE(PG8_SA(0, 1), a2 + hstepA, voffA);
            PG8_WAIT_V(8); PG8_WAIT_L(0); PG8_BAR; PG8_MMA(0, 0, At, B0); PG8_MMA(0, 1, At, B1); PG8_BAR; PG8_SCHED;
            PG8_LDA(At, 1, 1); PG8_STAGE(PG8_SB(1, 0), b3, voffB); PG8_STAGE(PG8_SB(1, 1), b3 + hstepB, voffB); PG8_STAGE(PG8_SA(1, 0), a3, voffA);
            PG8_WAIT_V(8); PG8_WAIT_L(0); PG8_BAR; PG8_MMA(1, 0, At, B0); PG8_MMA(1, 1, At, B1); PG8_BAR; PG8_SCHED;
        }
        if (wr == 0) PG8_BAR;
        E(acc, cur, wr, wc, fr, fq);
        if (!has_next) break;
#pragma unroll
        for (int a = 0; a < 2; ++a)
#pragma unroll
            for (int b = 0; b < 2; ++b)
#pragma unroll
                for (int m = 0; m < 4; ++m)
#pragma unroll
                    for (int n = 0; n < 2; ++n) acc[a][b][m][n] = (f32x4){0.f, 0.f, 0.f, 0.f};
        cur = nxt; cA = nA; cB = nB; ++ui;
        if (wr == 1) PG8_BAR;
    }
    PG8_WAIT_V(0);
    PG8_BAR;
#undef PG8_SA
#undef PG8_SB
#undef PG8_STAGE
#undef PG8_LDA
#undef PG8_LDB
#undef PG8_MMA
#undef PG8_WAIT_V
#undef PG8_WAIT_L
#undef PG8_BAR
#undef PG8_SCHED
}
}

struct Seg { const float* src; const float* scale; bf16_t* dst; int ld, c0, ncols, K, r0, map, item0; float cscale; };
constexpr int MAXSEG = 28;
struct Params {
    const float* in[19]; float* out; unsigned char* ws;
    int lo, hi, nseg, nitems;
    Seg seg[MAXSEG];
};

__device__ __forceinline__ void transpose_item(const Seg& s, int item, LAS float* scr, int lane) {
    const int nblk = (s.ncols + 31) / 32, kb = item / nblk, nb = item % nblk, k0 = 64 * kb, n0 = 32 * nb;
    const int c4 = 4 * (lane & 7), kr = lane >> 3;
    const bool ok = (s.src != nullptr) && (n0 + c4 + 3 < s.ncols);
    f32x4 v[8];
#pragma unroll
    for (int i = 0; i < 8; ++i) {
        v[i] = (f32x4){0.f, 0.f, 0.f, 0.f};
        if (ok) v[i] = *(const f32x4*)(s.src + (size_t)(k0 + kr + 8 * i) * s.ld + s.c0 + n0 + c4);
    }
#pragma unroll
    for (int i = 0; i < 8; ++i) {
        const int kk = kr + 8 * i;
        float sc = s.cscale; if (s.scale) sc *= s.scale[k0 + kk];
#pragma unroll
        for (int e = 0; e < 4; ++e) scr[kk * 33 + c4 + e] = v[i][e] * sc;
    }
    asm volatile("s_waitcnt lgkmcnt(0)" ::: "memory");
    const int c = lane & 7;
#pragma unroll
    for (int j = 0; j < 4; ++j) {
        const int nn = (lane >> 3) + 8 * j; const LAS float* sp = scr + (8 * c) * 33 + nn;
        u32x4 o; o.x = cvt_pk_bf16(sp[0 * 33], sp[1 * 33]); o.y = cvt_pk_bf16(sp[2 * 33], sp[3 * 33]); o.z = cvt_pk_bf16(sp[4 * 33], sp[5 * 33]); o.w = cvt_pk_bf16(sp[6 * 33], sp[7 * 33]);
        const int ncol = n0 + nn;
        const int drow = s.r0 + (s.map ? ((ncol >> 7) * 256 + (ncol & 127)) : ncol);
        *(u32x4*)(s.dst + (size_t)drow * s.K + k0 + 8 * c) = o;
    }
    asm volatile("s_waitcnt lgkmcnt(0)" ::: "memory");
}

__device__ __forceinline__ void sincos_reduced(float ang, float& c, float& s) {
    const double a = (double)ang;
    const double nq = __builtin_rint(a * 0.63661977236758134308);
    const float r = (float)(a - nq * 1.57079632679489661923);
    const int q = (int)nq & 3;
    const float r2 = r * r;
    const float sp = r + r * r2 * (-1.6666667163e-01f + r2 * (8.3333337680e-03f + r2 * (-1.9841270114e-04f + r2 * 2.7557314297e-06f)));
    const float cp = 1.f + r2 * (-0.5f + r2 * (4.1666667908e-02f + r2 * (-1.3888889225e-03f + r2 * (2.4801587642e-05f + r2 * -2.7557314297e-07f))));
    const float ss = (q & 1) ? cp : sp, cc = (q & 1) ? sp : cp;
    s = (q & 2) ? -ss : ss;
    c = ((q + 1) & 2) ? -cc : cc;
}

__device__ __forceinline__ void prologue(const Params& p, unsigned char* ws, LAS unsigned char* lds) {
    const int tid = tid_l(), lane = tid & 63, wave = tid >> 6;
    const int gw = blockIdx.x * 8 + wave, NGW = gridDim.x * 8;
    const int gt = blockIdx.x * 512 + tid, NGT = gridDim.x * 512;
    if (blockIdx.x == 0 && tid < 64) ((unsigned*)(ws + WS_CTL))[tid] = 0u;
    LAS float* scr = (LAS float*)(lds + wave * 8448);
    for (int it = gw; it < p.nitems; it += NGW) {
        int s = 0;
        while (s + 1 < p.nseg && it >= p.seg[s + 1].item0) ++s;
        transpose_item(p.seg[s], it - p.seg[s].item0, scr, lane);
    }
    const float* x = p.in[0]; bf16_t* xb = (bf16_t*)(ws + WS_XB);
    for (int i0 = gt; i0 < MTOK * DM / 8; i0 += 4 * NGT) {
        f32x4 a[4], b[4];
#pragma unroll
        for (int k = 0; k < 4; ++k) { const int i = i0 + k * NGT; if (i < MTOK * DM / 8) { a[k] = *(const f32x4*)(x + (size_t)i * 8); b[k] = *(const f32x4*)(x + (size_t)i * 8 + 4); } }
#pragma unroll
        for (int k = 0; k < 4; ++k) { const int i = i0 + k * NGT; if (i < MTOK * DM / 8) {
            u32x4 o; o.x = cvt_pk_bf16(a[k][0], a[k][1]); o.y = cvt_pk_bf16(a[k][2], a[k][3]); o.z = cvt_pk_bf16(b[k][0], b[k][1]); o.w = cvt_pk_bf16(b[k][2], b[k][3]);
            *(u32x4*)(xb + (size_t)i * 8) = o; } }
    }
    { float* wfT = (float*)(ws + WS_WF); const float* cdw = p.in[8];
      for (int i = gt; i < 8 * DM; i += NGT) { const int h = i >> 10, k = i & (DM - 1); wfT[i] = cdw[(size_t)k * 3080 + 1536 + h]; } }
    float* cosT = (float*)(ws + WS_ROPE); float* sinT = cosT + SEQ * 16;
    const float invf[16] = {1.000000000e+00f, 5.623413324e-01f, 3.162277639e-01f, 1.778279394e-01f, 1.000000015e-01f, 5.623413250e-02f, 3.162277490e-02f, 1.778279431e-02f,
                            9.999999776e-03f, 5.623413250e-03f, 3.162277630e-03f, 1.778279431e-03f, 1.000000047e-03f, 5.623413017e-04f, 3.162277571e-04f, 1.778279402e-04f};
    for (int i = gt; i < SEQ * 16; i += NGT) {
        const int pos = i >> 4, j = i & 15;
        float fr = invf[0];
#pragma unroll
        for (int k = 1; k < 16; ++k) fr = (j == k) ? invf[k] : fr;
        const float ang = (float)pos * fr;
        float c, s; sincos_reduced(ang, c, s);
        cosT[i] = c; sinT[i] = s;
    }
}

template <bool FL>
__device__ __forceinline__ void ln_phase(const float* y, float* outf, bf16_t* outb, float* stats, const float* g, const float* bt, const float* wf, const float* bforget, float* lsout) {
    const int tid = tid_l(), lane = tid & 63, wave = tid >> 6;
    const int gw = blockIdx.x * 8 + wave, NGW = gridDim.x * 8;
    f32x4 gv[4], bv[4];
#pragma unroll
    for (int j = 0; j < 4; ++j) { gv[j] = *(const f32x4*)(g + 256 * j + 4 * lane); bv[j] = *(const f32x4*)(bt + 256 * j + 4 * lane); }
    f32x4 wfr[FL ? 8 : 1][4];
    if (FL) {
#pragma unroll
        for (int h = 0; h < 8; ++h)
#pragma unroll
            for (int j = 0; j < 4; ++j) wfr[h][j] = *(const f32x4*)(wf + h * DM + 256 * j + 4 * lane);
    }
    f32x4 nx[4];
    if (gw < MTOK) {
#pragma unroll
        for (int j = 0; j < 4; ++j) nx[j] = *(const f32x4*)(y + (size_t)gw * DM + 4 * lane + 256 * j);
    }
    for (int row = gw; row < MTOK; row += NGW) {
        f32x4 v[4]; float s = 0.f;
#pragma unroll
        for (int j = 0; j < 4; ++j) { v[j] = nx[j]; s += (v[j][0] + v[j][1]) + (v[j][2] + v[j][3]); }
        if (row + NGW < MTOK) {
#pragma unroll
            for (int j = 0; j < 4; ++j) nx[j] = *(const f32x4*)(y + (size_t)(row + NGW) * DM + 4 * lane + 256 * j);
        }
        const float mean = wave_sum(s) * (1.f / DM); float s2 = 0.f;
#pragma unroll
        for (int j = 0; j < 4; ++j) { v[j] = v[j] - mean; s2 += (v[j][0] * v[j][0] + v[j][1] * v[j][1]) + (v[j][2] * v[j][2] + v[j][3] * v[j][3]); }
        const float rstd = 1.f / sqrtf(wave_sum(s2) * (1.f / DM) + LN_EPS);
        if (stats && lane == 0) { f32x2_t st = {mean, rstd}; *(f32x2_t*)(stats + 2 * (size_t)row) = st; }
        float facc[8];
#pragma unroll
        for (int h = 0; h < 8; ++h) facc[h] = 0.f;
#pragma unroll
        for (int j = 0; j < 4; ++j) {
            const f32x4 o = v[j] * rstd * gv[j] + bv[j];
            if (FL) {
#pragma unroll
                for (int h = 0; h < 8; ++h) facc[h] += (o[0] * wfr[h][j][0] + o[1] * wfr[h][j][1]) + (o[2] * wfr[h][j][2] + o[3] * wfr[h][j][3]);
            }
            if (outf) *(f32x4*)(outf + (size_t)row * DM + 256 * j + 4 * lane) = o;
            if (outb) { u32x2 w; w.x = cvt_pk_bf16(o[0], o[1]); w.y = cvt_pk_bf16(o[2], o[3]); *(u32x2*)(outb + (size_t)row * DM + 256 * j + 4 * lane) = w; }
        }
        if (FL) {
            float f4[4], f2[2], f1;
            { const bool up = (lane & 32) != 0;
#pragma unroll
              for (int i = 0; i < 4; ++i) { const float keep = up ? facc[4 + i] : facc[i], give = up ? facc[i] : facc[4 + i]; f4[i] = keep + __shfl_xor(give, 32); } }
            { const bool up = (lane & 16) != 0;
#pragma unroll
              for (int i = 0; i < 2; ++i) { const float keep = up ? f4[2 + i] : f4[i], give = up ? f4[i] : f4[2 + i]; f2[i] = keep + __shfl_xor(give, 16); } }
            { const bool up = (lane & 8) != 0; const float keep = up ? f2[1] : f2[0], give = up ? f2[0] : f2[1]; f1 = keep + __shfl_xor(give, 8); }
            f1 += __shfl_xor(f1, 4); f1 += __shfl_xor(f1, 2); f1 += __shfl_xor(f1, 1);
            if ((lane & 7) == 0) { const int h = ((lane >> 5) & 1) * 4 + ((lane >> 4) & 1) * 2 + ((lane >> 3) & 1);
                const float z = f1 + bforget[h]; lsout[(size_t)row * 8 + h] = fminf(z, 0.f) - log1pf(expf(-fabsf(z))); }
        }
    }
}

__device__ __forceinline__ void rownorm_phase(unsigned char* ws) {
    const int tid = tid_l(), lane = tid & 63, wave = tid >> 6;
    const int gw = blockIdx.x * 8 + wave, NGW = gridDim.x * 8;
    const bf16_t* proj = (const bf16_t*)(ws + WS_BIG);
    float* rsq = (float*)(ws + WS_RSQ); float* rskv = (float*)(ws + WS_RSKV);
    bf16_t* kro = (bf16_t*)(ws + WS_KROPE);
    const float* cosT = (const float*)(ws + WS_ROPE); const float* sinT = cosT + SEQ * 16;
    const int sub = lane >> 4, l16 = lane & 15;
    for (int r4 = gw * 4; r4 < MTOK; r4 += NGW * 4) {
        const int row = r4 + sub;
        const bf16_t* pr = proj + (size_t)row * N0;
        float sq = 0.f, skv = 0.f;
        u32x4 vq[3], vk[2];
#pragma unroll
        for (int i = 0; i < 3; ++i) vq[i] = *(const u32x4*)(pr + (l16 + 16 * i) * 8);
#pragma unroll
        for (int i = 0; i < 2; ++i) vk[i] = *(const u32x4*)(pr + 384 + (l16 + 16 * i) * 8);
        const float x1 = __uint_as_float((unsigned)pr[640 + l16] << 16), x2 = __uint_as_float((unsigned)pr[656 + l16] << 16);
#pragma unroll
        for (int i = 0; i < 3; ++i)
#pragma unroll
            for (int e = 0; e < 4; ++e) { const float a = bf_lo(vq[i][e]), b = bf_hi(vq[i][e]); sq += a * a + b * b; }
#pragma unroll
        for (int i = 0; i < 2; ++i)
#pragma unroll
            for (int e = 0; e < 4; ++e) { const float a = bf_lo(vk[i][e]), b = bf_hi(vk[i][e]); skv += a * a + b * b; }
#pragma unroll
        for (int o = 1; o < 16; o <<= 1) { sq += __shfl_xor(sq, o); skv += __shfl_xor(skv, o); }
        if (l16 == 0) { rsq[row] = 1.f / sqrtf(sq * (1.f / 384.f) + RMS_EPS); rskv[row] = 1.f / sqrtf(skv * (1.f / 256.f) + RMS_EPS); }
        {
            const int pos = row & (SEQ - 1);
            const float c = cosT[pos * 16 + l16], sn = sinT[pos * 16 + l16];
            const unsigned o = cvt_pk_bf16(x1 * c - x2 * sn, x1 * sn + x2 * c);
            kro[(size_t)row * 32 + l16] = (bf16_t)(o & 0xffffu); kro[(size_t)row * 32 + 16 + l16] = (bf16_t)(o >> 16);
        }
    }
}

__device__ __forceinline__ void scan_phase(const Params& p, unsigned char* ws, LAS unsigned char* lds) {
    const int tid = tid_l(), lane = tid & 63, wave = tid >> 6;
    const float* flog = (const float*)(ws + WS_FLOG); float* cum = (float*)(ws + WS_CUM);
    LAS float* wtot = (LAS float*)lds;
    for (int bh = blockIdx.x; bh < 64; bh += gridDim.x) {
        const int b = bh >> 3, h = bh & 7;
        float v[8]; float run = 0.f;
#pragma unroll
        for (int i = 0; i < 8; ++i) {
            run += flog[((size_t)b * SEQ + tid * 8 + i) * 8 + h]; v[i] = run;
        }
        float inc = run;
#pragma unroll
        for (int o = 1; o < 64; o <<= 1) { const float t = __shfl_up(inc, o); if (lane >= o) inc += t; }
        __syncthreads();
        if (lane == 63) wtot[wave] = inc;
        __syncthreads();
        float off = inc - run;
        for (int w2 = 0; w2 < wave; ++w2) off += wtot[w2];
#pragma unroll
        for (int i = 0; i < 8; ++i) cum[(size_t)bh * SEQ + tid * 8 + i] = (off + v[i]) * LOG2E;
    }
    __syncthreads();
}

constexpr int AT_KBUF = 12288, AT_NBUF = 4, AT_VOFF = AT_NBUF * AT_KBUF, AT_VBUF = 8192, AT_REL = AT_VOFF + AT_NBUF * AT_VBUF, AT_CK = AT_REL + 1280, AT_UNIT = AT_CK + AT_NBUF * 1024;
constexpr float NEG_BIG = -1e30f;
#define MX3(a, b, c) __builtin_fmaxf(__builtin_fmaxf((a), (b)), (c))
typedef __bf16 bf16x2_t __attribute__((ext_vector_type(2)));
__device__ __forceinline__ unsigned cvtpk(float lo, float hi) { f32x2_t v = {lo, hi}; bf16x2_t b = __builtin_convertvector(v, bf16x2_t); return __builtin_bit_cast(unsigned, b); }
__device__ __forceinline__ void glds16(const void* gsrc, unsigned lds_dst) { unsigned keep;
    asm volatile("s_mov_b32 %0, m0\n\ts_mov_b32 m0, %2\n\ts_nop 0\n\tglobal_load_lds_dwordx4 %1, off\n\ts_mov_b32 m0, %0" : "=&s"(keep) : "v"(gsrc), "s"(lds_dst) : "memory"); }

template <int TYPE>
__device__ __forceinline__ void attn_unit(const Params& p, unsigned char* ws, int bh, int qb, LAS unsigned char* lds) {
    constexpr int DQK = (TYPE == 0) ? 96 : 64, ND = DQK / 16;
    const int tid = tid_l(), lane = tid & 63, w = __builtin_amdgcn_readfirstlane(tid >> 6), ql = lane & 31, hi = lane >> 5;
    const int b = bh >> 3, h = (bh & 7) + ((TYPE == 1) ? (w >> 2) : 0);
    const size_t rb = (size_t)b * SEQ;
    const int q0 = (TYPE == 1) ? qb * 128 : qb * 256, qpos = q0 + 32 * ((TYPE == 1) ? (w & 3) : w) + ql;
    const bf16_t* PROJ = (const bf16_t*)(ws + WS_BIG);
    const bf16_t *Qp, *K0p, *Vp; int ldq, ldk, ocol;
    if (TYPE == 0) { Qp = (const bf16_t*)(ws + WS_Q) + h * 96; ldq = 768; K0p = (const bf16_t*)(ws + WS_KV) + h * 128; Vp = K0p + 64; ldk = 1024; ocol = h * 64; }
    else if (TYPE == 1) { Qp = PROJ + 672 + h * 64; ldq = N0; K0p = PROJ + 1184 + (h >> 2) * 64; Vp = PROJ + 1312 + (h >> 2) * 64; ldk = N0; ocol = 512 + h * 64; }
    else if (TYPE == 2) { Qp = PROJ + h * 64; ldq = 512; K0p = PROJ + (size_t)1 * MTOK * 512 + h * 64; Vp = PROJ + (size_t)2 * MTOK * 512 + h * 64; ldk = 512; ocol = h * 64; }
    else { Qp = PROJ + (size_t)3 * MTOK * 512 + h * 64; ldq = 512; K0p = PROJ + (size_t)4 * MTOK * 512 + h * 64; Vp = PROJ + (size_t)5 * MTOK * 512 + h * 64; ldk = 512; ocol = 512 + h * 64; }

    const float* cumk = (const float*)(ws + WS_CUM) + (size_t)bh * SEQ;
    const int cw = (TYPE == 1) ? 2 * qb + ((w & 3) >> 1) : 4 * qb + (w >> 1), t_hi = (TYPE == 1) ? 2 * qb + 1 : 4 * qb + 3;
    int t_lo = 0, w_lo = 0;
    if (TYPE == 1) { t_lo = max(0, 2 * qb - 2); w_lo = max(0, cw - 2); }
    if (TYPE == 3) { t_lo = max(0, 4 * qb - 8); w_lo = max(0, cw - 8); }

    const unsigned ldsb = (unsigned)(size_t)lds;
    const bf16_t* kgl = K0p + (rb + lane) * ldk + w * 8;
    const bf16_t* rgl = (const bf16_t*)(ws + WS_KROPE) + (rb + lane) * 32 + (w & 3) * 8;
    const bf16_t* vgl = Vp + (rb + 16 * (w & 3) + (lane >> 2)) * ldk + (w >> 2) * 32 + (lane & 3) * 8;
#define AT_LOADK(t, buf) do { glds16(kgl + (size_t)(t) * 64 * ldk, ldsb + (buf) * AT_KBUF + w * 1024); \
        if (TYPE == 0 && w < 4) glds16(rgl + (size_t)(t) * 64 * 32, ldsb + (buf) * AT_KBUF + (8 + w) * 1024); } while (0)
#define AT_LOADV(t, buf) do { glds16(vgl + (size_t)(t) * 64 * ldk, ldsb + AT_VOFF + (buf) * AT_VBUF + (w >> 2) * 4096 + (w & 3) * 1024); \
        if (TYPE == 2 && w == 7) glds16(cumk + (t) * 64 + lane * 4, ldsb + AT_CK + (buf) * 1024); } while (0)
#define AT_WAITBAR_FULL() do { if ((TYPE == 0 && w < 4) || (TYPE == 2 && w == 7)) asm volatile("s_waitcnt vmcnt(3) lgkmcnt(0)\n\ts_barrier" ::: "memory"); \
        else asm volatile("s_waitcnt vmcnt(2) lgkmcnt(0)\n\ts_barrier" ::: "memory"); } while (0)
#define AT_WAITBAR_ALL() asm volatile("s_waitcnt vmcnt(0) lgkmcnt(0)\n\ts_barrier" ::: "memory")

    AT_LOADK(t_lo, 0); AT_LOADV(t_lo, 0); AT_LOADK(t_lo + 1, 1); AT_LOADV(t_lo + 1, 1);
    bf16x8 qf[ND];
    {
        const bf16_t* qp = Qp + (rb + qpos) * ldq + 8 * hi;
#pragma unroll
        for (int d0 = 0; d0 < ND; ++d0) qf[d0] = *(const bf16x8*)(qp + 16 * d0);
        if (TYPE == 0) {
            const float* cosT = (const float*)(ws + WS_ROPE); const float* sinT = cosT + SEQ * 16;
            const u32x4 a = __builtin_bit_cast(u32x4, qf[4]), bq = __builtin_bit_cast(u32x4, qf[5]);
            const f32x4 c0 = *(const f32x4*)(cosT + qpos * 16 + 8 * hi), c1 = *(const f32x4*)(cosT + qpos * 16 + 8 * hi + 4);
            const f32x4 s0 = *(const f32x4*)(sinT + qpos * 16 + 8 * hi), s1 = *(const f32x4*)(sinT + qpos * 16 + 8 * hi + 4);
            u32x4 o1, o2;
#pragma unroll
            for (int e = 0; e < 4; ++e) {
                const float x1l = bf_lo(a[e]), x1h = bf_hi(a[e]), x2l = bf_lo(bq[e]), x2h = bf_hi(bq[e]);
                const float cl = (e < 2) ? c0[2 * e] : c1[2 * e - 4], ch = (e < 2) ? c0[2 * e + 1] : c1[2 * e - 3];
                const float sl = (e < 2) ? s0[2 * e] : s1[2 * e - 4], sh = (e < 2) ? s0[2 * e + 1] : s1[2 * e - 3];
                o1[e] = cvtpk(x1l * cl - x2l * sl, x1h * ch - x2h * sh);
                o2[e] = cvtpk(x1l * sl + x2l * cl, x1h * sh + x2h * ch);
            }
            qf[4] = __builtin_bit_cast(bf16x8, o1); qf[5] = __builtin_bit_cast(bf16x8, o2);
        }
    }
#pragma unroll
    for (int d0 = 0; d0 < ND; ++d0) asm volatile("" : "+v"(qf[d0]));
    float cq2 = 0.f, slope2 = 0.f, rfar = 0.f;
    if (TYPE == 2) cq2 = cumk[qpos];
    if (TYPE == 1) slope2 = __builtin_amdgcn_exp2f(-(float)(h + 1)) * LOG2E;
    LAS float* relb = (LAS float*)(lds + AT_REL);
    if (TYPE == 3) { if (tid < 320) relb[tid] = p.in[10][tid * 8 + h] * LOG2E; rfar = p.in[10][319 * 8 + h] * LOG2E; }
    asm volatile("" : "+v"(cq2), "+v"(rfar));
    const float qposf = (float)qpos;

    f32x16 oT0, oT1, negm, s0, s1;
#pragma unroll
    for (int r = 0; r < 16; ++r) { oT0[r] = 0.f; oT1[r] = 0.f; negm[r] = cq2; s0[r] = 0.f; s1[r] = 0.f; }
    float mrow = 0.f, lrow = 0.f;
    const unsigned kfrag = hi * 1024 + ql * 16;
    const unsigned vfrag = AT_VOFF + (4 * hi + ((lane & 15) >> 2)) * 64 + ((lane >> 4) & 1) * 32 + (lane & 3) * 8;
#define SBAR() __builtin_amdgcn_sched_barrier(0)

    AT_WAITBAR_ALL();
    const int npair = (t_hi - t_lo + 1) >> 1;
    for (int pp = 0; pp < npair; ++pp) {
        const int sb = (pp & 1) * 2;
        if (pp + 1 < npair) { const int tn = t_lo + 2 * pp + 2; AT_LOADK(tn, sb ^ 2); AT_LOADV(tn, sb ^ 2); AT_LOADK(tn + 1, (sb ^ 2) + 1); AT_LOADV(tn + 1, (sb ^ 2) + 1); }
#pragma unroll 1
        for (int u2 = 0; u2 < 2; ++u2) {
        const int t = t_lo + 2 * pp + u2, bc = sb + u2;
        if (t >= w_lo && t <= cw) {
            bf16x8 kf0[ND], kf1[ND];
            const LAS unsigned char* kb = lds + bc * AT_KBUF + kfrag;
#pragma unroll
            for (int d0 = 0; d0 < ND; ++d0) { kf0[d0] = *(const LAS bf16x8*)(kb + d0 * 2048); kf1[d0] = *(const LAS bf16x8*)(kb + d0 * 2048 + 512); }
            SBAR();
#pragma unroll
            for (int d0 = 0; d0 < ND; ++d0) {
                if (d0 == 0) { s0 = __builtin_amdgcn_mfma_f32_32x32x16_bf16(kf0[0], qf[0], negm, 0, 0, 0); s1 = __builtin_amdgcn_mfma_f32_32x32x16_bf16(kf1[0], qf[0], negm, 0, 0, 0); }
                else { s0 = __builtin_amdgcn_mfma_f32_32x32x16_bf16(kf0[d0], qf[d0], s0, 0, 0, 0); s1 = __builtin_amdgcn_mfma_f32_32x32x16_bf16(kf1[d0], qf[d0], s1, 0, 0, 0); }
            }
            SBAR();
            long vl0[4], vh0[4], vl1[4], vh1[4];
            const LAS unsigned char* vb = lds + bc * AT_VBUF + vfrag;
#pragma unroll
            for (int ks = 0; ks < 4; ++ks) {
                vl0[ks] = __builtin_bit_cast(long, __builtin_amdgcn_ds_read_tr16_b64_v4i16((LAS s16x4*)(vb + ks * 1024)));
                vh0[ks] = __builtin_bit_cast(long, __builtin_amdgcn_ds_read_tr16_b64_v4i16((LAS s16x4*)(vb + ks * 1024 + 512)));
                vl1[ks] = __builtin_bit_cast(long, __builtin_amdgcn_ds_read_tr16_b64_v4i16((LAS s16x4*)(vb + 4096 + ks * 1024)));
                vh1[ks] = __builtin_bit_cast(long, __builtin_amdgcn_ds_read_tr16_b64_v4i16((LAS s16x4*)(vb + 4096 + ks * 1024 + 512)));
            }
            SBAR();
            const int kbase = 64 * t + 4 * hi;
            if (TYPE == 1) {
                const float d0f = qposf - (float)kbase;
#pragma unroll
                for (int r = 0; r < 16; ++r) { const float off = (float)((r & 3) + 8 * (r >> 2));
                    s0[r] = s0[r] - slope2 * fabsf(d0f - off); s1[r] = s1[r] - slope2 * fabsf(d0f - off - 32.f); }
            } else if (TYPE == 2) {
                const LAS float* ck = (const LAS float*)(lds + AT_CK + bc * 1024) + 4 * hi;
#pragma unroll
                for (int g4 = 0; g4 < 4; ++g4) {
                    const f32x4 c0 = *(const LAS f32x4*)(ck + 8 * g4), c1 = *(const LAS f32x4*)(ck + 8 * g4 + 32);
#pragma unroll
                    for (int e = 0; e < 4; ++e) { s0[4 * g4 + e] -= c0[e]; s1[4 * g4 + e] -= c1[e]; }
                }
                if (t == cw) {
#pragma unroll
                    for (int r = 0; r < 16; ++r) { const int s = kbase + (r & 3) + 8 * (r >> 2);
                        s0[r] = (s <= qpos) ? s0[r] : NEG_BIG; s1[r] = (s + 32 <= qpos) ? s1[r] : NEG_BIG; }
                }
            } else if (TYPE == 3) {
                if (cw - t >= 5) {
#pragma unroll
                    for (int r = 0; r < 16; ++r) { s0[r] += rfar; s1[r] += rfar; }
                } else {
                    const int dq = qpos - kbase;
#pragma unroll
                    for (int r = 0; r < 16; ++r) { const int d = dq - ((r & 3) + 8 * (r >> 2));
                        s0[r] += relb[min(d, 256) + 63]; s1[r] += relb[min(d - 32, 256) + 63]; }
                }
            }
            float ma = MX3(s0[0], s0[1], s1[0]), mb = MX3(s0[2], s0[3], s1[1]); ma = MX3(ma, s1[2], s1[3]);
#pragma unroll
            for (int r = 4; r < 16; r += 4) { ma = MX3(ma, s0[r], s0[r + 1]); mb = MX3(mb, s0[r + 2], s0[r + 3]); ma = MX3(ma, s1[r], s1[r + 1]); mb = MX3(mb, s1[r + 2], s1[r + 3]); }
            const float mx = half_max(fmaxf(ma, mb));
            if (__any(mx > 8.f)) {
                const float dl = fmaxf(mx, 0.f);
                mrow += dl;
                const float f = __builtin_amdgcn_exp2f(-dl);
                lrow *= f;
#pragma unroll
                for (int r = 0; r < 16; ++r) { s0[r] -= dl; s1[r] -= dl; negm[r] -= dl; oT0[r] *= f; oT1[r] *= f; }
            }
            float la = 0.f, lb = 0.f, lc = 0.f, ld = 0.f;
            bf16x8 pf[4];
#pragma unroll
            for (int r = 0; r < 16; r += 2) { s0[r] = __builtin_amdgcn_exp2f(s0[r]); s0[r + 1] = __builtin_amdgcn_exp2f(s0[r + 1]); la += s0[r]; lb += s0[r + 1]; }
            { u32x4 w0, w1;
              w0.x = cvtpk(s0[0], s0[1]); w0.y = cvtpk(s0[2], s0[3]); w0.z = cvtpk(s0[4], s0[5]); w0.w = cvtpk(s0[6], s0[7]);
              w1.x = cvtpk(s0[8], s0[9]); w1.y = cvtpk(s0[10], s0[11]); w1.z = cvtpk(s0[12], s0[13]); w1.w = cvtpk(s0[14], s0[15]);
              pf[0] = __builtin_bit_cast(bf16x8, w0); pf[1] = __builtin_bit_cast(bf16x8, w1); }
            SBAR();
#define AT_PV(ks) do { const bf16x8 v0_ = __builtin_bit_cast(bf16x8, (i64x2){vl0[ks], vh0[ks]}); const bf16x8 v1_ = __builtin_bit_cast(bf16x8, (i64x2){vl1[ks], vh1[ks]}); \
                oT0 = __builtin_amdgcn_mfma_f32_32x32x16_bf16(v0_, pf[ks], oT0, 0, 0, 0); oT1 = __builtin_amdgcn_mfma_f32_32x32x16_bf16(v1_, pf[ks], oT1, 0, 0, 0); } while (0)
            AT_PV(0);
            SBAR();
#pragma unroll
            for (int r = 0; r < 8; r += 2) { s1[r] = __builtin_amdgcn_exp2f(s1[r]); s1[r + 1] = __builtin_amdgcn_exp2f(s1[r + 1]); lc += s1[r]; ld += s1[r + 1]; }
            SBAR();
            AT_PV(1);
            SBAR();
#pragma unroll
            for (int r = 8; r < 16; r += 2) { s1[r] = __builtin_amdgcn_exp2f(s1[r]); s1[r + 1] = __builtin_amdgcn_exp2f(s1[r + 1]); lc += s1[r]; ld += s1[r + 1]; }
            lrow += (la + lb) + (lc + ld);
            { u32x4 w2, w3;
              w2.x = cvtpk(s1[0], s1[1]); w2.y = cvtpk(s1[2], s1[3]); w2.z = cvtpk(s1[4], s1[5]); w2.w = cvtpk(s1[6], s1[7]);
              w3.x = cvtpk(s1[8], s1[9]); w3.y = cvtpk(s1[10], s1[11]); w3.z = cvtpk(s1[12], s1[13]); w3.w = cvtpk(s1[14], s1[15]);
              pf[2] = __builtin_bit_cast(bf16x8, w2); pf[3] = __builtin_bit_cast(bf16x8, w3); }
            SBAR();
            AT_PV(2); AT_PV(3);
#undef AT_PV
            SBAR();
        }
        }
        AT_WAITBAR_ALL();
    }
#undef SBAR
#undef AT_LOADK
#undef AT_LOADV
#undef AT_WAITBAR_FULL
#undef AT_WAITBAR_ALL
    float ltot = half_sum(lrow);
    if (TYPE == 1) ltot += __builtin_amdgcn_exp2f(p.in[6][h] * LOG2E - mrow);
    const float inv = 1.f / ltot;
    bf16_t* op = (bf16_t*)(ws + WS_O) + (rb + qpos) * DM + ocol + 4 * hi;
#pragma unroll
    for (int g4 = 0; g4 < 4; ++g4) {
        u32x2 w0, w1;
        w0.x = cvtpk(oT0[4 * g4] * inv, oT0[4 * g4 + 1] * inv); w0.y = cvtpk(oT0[4 * g4 + 2] * inv, oT0[4 * g4 + 3] * inv);
        w1.x = cvtpk(oT1[4 * g4] * inv, oT1[4 * g4 + 1] * inv); w1.y = cvtpk(oT1[4 * g4 + 2] * inv, oT1[4 * g4 + 3] * inv);
        *(u32x2*)(op + 8 * g4) = w0; *(u32x2*)(op + 32 + 8 * g4) = w1;
    }
}

template <int TCAUSAL, int TBAND>
__device__ __forceinline__ void attn_phase(const Params& p, unsigned char* ws, LAS unsigned char* lds, unsigned* ctr) {
    LAS int* su = (LAS int*)(lds + AT_UNIT);
    const int tid0 = tid_l();
    const int myq = (int)((unsigned)__builtin_amdgcn_s_getreg((3 << 11) | 20) & 7u);
    for (int qi = 0; qi < 8; ++qi) {
        const int q = (myq + qi) & 7;
        unsigned* qc = ctr + q;
        __syncthreads();
        if (tid0 == 0) su[0] = (int)atomicAdd(qc, 1u);
        __syncthreads();
        int cur = 0;
        for (;;) {
            const int u = su[cur];
            if (u >= 256) break;
            int nxt = 0;
            if (tid0 == 0) nxt = (int)atomicAdd(qc, 1u);
            if (u < 128) attn_unit<TCAUSAL>(p, ws, q + 8 * (u & 7), 15 - (u >> 3), lds);
            else if (TBAND == 1) { const int j = u - 128, g = q + 8 * (j & 1), hp = (g & 1) * 2 + ((j >> 1) & 1); attn_unit<TBAND>(p, ws, (g >> 1) * 8 + hp * 2, 31 - (j >> 2), lds); }
            else { const int j = u - 128; attn_unit<TBAND>(p, ws, q + 8 * (j & 7), 15 - (j >> 3), lds); }
            if (tid0 == 0) su[cur ^ 1] = nxt;
            __syncthreads();
            cur ^= 1;
        }
    }
}

#define XB_TMO      128
#define XB_XCNT(j)  (256  + 64 * (j))
#define XB_XSUB(j)  (1280 + 64 * (j))
#define XB_XGEN(j)  (2304 + 64 * (j))
#define XB_TOP      3328
#define XB_TOPGEN   3392
#define XCD_BAR_WORDS 3456
#define XB_SPIN_CAP (1u << 18)
__device__ __forceinline__ unsigned xb_ld(unsigned* p)              { return __hip_atomic_load(p, __ATOMIC_RELAXED, __HIP_MEMORY_SCOPE_AGENT); }
__device__ __forceinline__ unsigned xb_add(unsigned* p, unsigned v) { return __hip_atomic_fetch_add(p, v, __ATOMIC_RELAXED, __HIP_MEMORY_SCOPE_AGENT); }
__device__ __forceinline__ unsigned xb_xcc_id() { return (unsigned)__builtin_amdgcn_s_getreg((3 << 11) | 20) & 0xFu; }
#define XB_SPIN(cond, bar) do { unsigned _sp = 0; while (cond) { __builtin_amdgcn_s_sleep(1); \
    if ((++_sp & 255u) == 0u) { if (xb_ld(&(bar)[XB_TMO])) break; if (_sp > XB_SPIN_CAP) { atomicAdd(&(bar)[XB_TMO], 1u); break; } } } } while (0)
struct XcdBarrier { unsigned* bar; unsigned x; volatile LAS unsigned* st; };
__device__ __forceinline__ XcdBarrier xcd_barrier_post(unsigned* bar, volatile LAS unsigned* st) {
    XcdBarrier b; b.bar = bar; b.x = xb_xcc_id(); b.st = st;
    if (threadIdx.x == 0) (void)xb_add(&bar[XB_XCNT(b.x)], 1u);
    return b;
}
__device__ __forceinline__ void xcd_barrier_complete(unsigned* bar, unsigned x, unsigned& nloc, unsigned& nx) {
    const unsigned G = gridDim.x * gridDim.y * gridDim.z;
    unsigned sum, cnt, mine, sp = 0u;
    for (;;) {
        sum = 0u; cnt = 0u; mine = 0u;
#pragma unroll
        for (unsigned j = 0; j < 16; ++j) { const unsigned c = xb_ld(&bar[XB_XCNT(j)]); sum += c; cnt += (c > 0u) ? 1u : 0u; mine = (j == x) ? c : mine; }
        if (sum == G) break;
        __builtin_amdgcn_s_sleep(1);
        if ((++sp & 255u) == 0u) { if (xb_ld(&bar[XB_TMO])) break; if (sp > XB_SPIN_CAP) { atomicAdd(&bar[XB_TMO], 1u); break; } }
    }
    nloc = mine > 0u ? mine : 1u; nx = cnt > 0u ? cnt : 1u;
}
__device__ __forceinline__ void xcd_barrier(const XcdBarrier& b) {
    asm volatile("s_waitcnt vmcnt(0)" ::: "memory");
    __syncthreads();
    if (threadIdx.x == 0) {
        unsigned* bar = b.bar;
        __builtin_amdgcn_s_waitcnt(0);
        unsigned nloc = b.st[0], nx = b.st[1];
        if (nloc == 0u) { xcd_barrier_complete(bar, b.x, nloc, nx); b.st[0] = nloc; b.st[1] = nx; }
        const unsigned old = xb_add(&bar[XB_XSUB(b.x)], 1u);
        const unsigned gen = old / nloc;
        if (old + 1u == (gen + 1u) * nloc) {
            __builtin_amdgcn_fence(__ATOMIC_RELEASE, "agent");
            asm volatile("s_waitcnt vmcnt(0)" ::: "memory");
            const unsigned og = xb_add(&bar[XB_TOP], 1u);
            const unsigned tg = og / nx;
            if (og + 1u == (tg + 1u) * nx) xb_add(&bar[XB_TOPGEN], 1u);
            else XB_SPIN(xb_ld(&bar[XB_TOPGEN]) == tg, bar);
            __builtin_amdgcn_fence(__ATOMIC_ACQUIRE, "agent");
            xb_add(&bar[XB_XGEN(b.x)], 1u);
            asm volatile("s_waitcnt vmcnt(0)" ::: "memory");
        } else {
            XB_SPIN(xb_ld(&bar[XB_XGEN(b.x)]) == gen, bar);
            __builtin_amdgcn_fence(__ATOMIC_ACQUIRE, "agent");
            asm volatile("s_waitcnt vmcnt(0)" ::: "memory");
        }
    }
    __syncthreads();
}

__global__ void __launch_bounds__(512, 2) mega(Params p) {
    extern __shared__ __attribute__((aligned(16))) unsigned char lds_raw[];
    LAS unsigned char* lds = (LAS unsigned char*)lds_raw;
    cg::grid_group grid = cg::this_grid();
    volatile LAS unsigned* bst = (volatile LAS unsigned*)(lds + LDS_BARW);
    if (threadIdx.x < 2) bst[threadIdx.x] = 0u;
    __syncthreads();
    XcdBarrier xbar = xcd_barrier_post((unsigned*)(p.ws + WS_BAR), bst);

    for (int ph = p.lo; ph < p.hi; ++ph) {
        if (ph == 11) continue;
        __attribute__((address_space(1))) unsigned char* gws = (__attribute__((address_space(1))) unsigned char*)p.ws;
        __attribute__((address_space(1))) float* gY = (__attribute__((address_space(1))) float*)p.out;
        asm volatile("" : "+s"(gws), "+s"(gY));
        unsigned char* ws = (unsigned char*)gws; float* Y = (float*)gY;
        bf16_t* XB = (bf16_t*)(ws + WS_XB);
        bf16_t* BIG = (bf16_t*)(ws + WS_BIG);
        bf16_t* OB = (bf16_t*)(ws + WS_O);
        unsigned* ctl = (unsigned*)(ws + WS_CTL);
        int ng = 0; pg8::Gemm g0, g1; pg8::Epi<0> e0, e1;
        e0.mode = 0; e0.O = nullptr; e0.ldc = 0; e0.rowscale = nullptr; e0.F32 = nullptr; e0.f32tile = -1; e0.res = nullptr; e0.out = nullptr; e0.lnstats = nullptr; e0.lng = nullptr; e0.lnb = nullptr; e1 = e0;
        g0.A = nullptr; g0.Bt = nullptr; g0.M = MTOK; g0.N = 0; g0.K = 0; g0.lda = 0; g0.ldb = 0; g1 = g0;
        const int L = (ph >= 10) ? 1 : 0;
        switch (ph) {
            case 1:  ng = 1; g0.A = XB; g0.lda = DM; g0.Bt = (const bf16_t*)(ws + WS_WIN0); g0.ldb = DM; g0.N = N0; g0.K = DM; e0.O = BIG; e0.ldc = N0; break;
            case 3:  ng = 2; g0.A = BIG; g0.lda = N0; g0.Bt = (const bf16_t*)(ws + WS_WUQ); g0.ldb = 384; g0.N = 768; g0.K = 384; e0.O = (bf16_t*)(ws + WS_Q); e0.ldc = 768; e0.rowscale = (const float*)(ws + WS_RSQ);
                     g1.A = BIG + 384; g1.lda = N0; g1.Bt = (const bf16_t*)(ws + WS_WUKV); g1.ldb = 256; g1.N = 1024; g1.K = 256; e1.O = (bf16_t*)(ws + WS_KV); e1.ldc = 1024; e1.rowscale = (const float*)(ws + WS_RSKV); break;
            case 5:  case 13: ng = 1; g0.A = OB; g0.lda = DM; g0.Bt = (const bf16_t*)(ws + (L ? WS_WOUT1 : WS_WOUT0)); g0.ldb = DM; g0.N = DM; g0.K = DM; e0.mode = 2; e0.res = (ph == 5) ? p.in[0] : Y; e0.out = Y;
                     if (ph == 13) { e0.lnstats = (const float*)(ws + WS_STATS); e0.lng = p.in[17]; e0.lnb = p.in[18]; } break;
            case 7:  case 15: ng = 1; g0.A = XB; g0.lda = DM; g0.Bt = (const bf16_t*)(ws + (L ? WS_WGU1 : WS_WGU0)); g0.ldb = DM; g0.N = 2 * DFF; g0.K = DM; e0.mode = 1; e0.O = BIG; break;
            case 8:  case 16: ng = 1; g0.A = BIG; g0.lda = DFF; g0.Bt = (const bf16_t*)(ws + (L ? WS_WDN1 : WS_WDN0)); g0.ldb = DFF; g0.N = DM; g0.K = DFF; e0.mode = 2; e0.res = Y; e0.out = Y; e0.lnstats = (const float*)(ws + WS_STATS); e0.lng = p.in[12] + L * DM; e0.lnb = p.in[13] + L * DM; break;
            case 10: ng = 1; g0.A = XB; g0.lda = DM; g0.Bt = (const bf16_t*)(ws + WS_WIN1); g0.ldb = DM; g0.N = N1; g0.K = DM; e0.O = BIG; e0.ldc = 512; e0.f32tile = 512; break;
            default: break;
        }
        const int nrep = (ph == PROBE_REP) ? 2 : 1;
        for (int rep = 0; rep < nrep; ++rep) {
        if (ph == 10) scan_phase(p, ws, lds);
        for (int j = 0; j < ng; ++j) {
            const pg8::Gemm gg = j ? g1 : g0; const pg8::Epi<0> ee = j ? e1 : e0;
            pg8::StaticOrder S; S.init(gg.M, gg.N, (int)gridDim.x, (int)blockIdx.x);
#define EPI_COPY(T, x) pg8::Epi<T> x; x.mode = ee.mode; x.O = ee.O; x.ldc = ee.ldc; x.rowscale = ee.rowscale; x.F32 = ee.F32; x.f32tile = ee.f32tile; x.res = ee.res; x.out = ee.out; x.lnstats = ee.lnstats; x.lng = ee.lng; x.lnb = ee.lnb
            if (ee.mode == 0 && ee.rowscale == nullptr) pg8::gemm_phase(lds, gg, S, ee);
            else if (ee.mode == 0) { EPI_COPY(4, e4t); pg8::gemm_phase(lds, gg, S, e4t); }
            else if (ee.mode == 1) { EPI_COPY(1, e1t); pg8::gemm_phase(lds, gg, S, e1t); }
            else if (ee.lnstats == nullptr) { EPI_COPY(2, e2t); pg8::gemm_phase(lds, gg, S, e2t); }
            else { EPI_COPY(3, e3t); pg8::gemm_phase(lds, gg, S, e3t); }
#undef EPI_COPY
        }
        if (ph == 0) prologue(p, ws, lds);
        else if (ph == 2) rownorm_phase(ws);
        else if (ph == 4) attn_phase<0, 1>(p, ws, lds, ctl + 64 + 16 * rep);
        else if (ph == 12) attn_phase<2, 3>(p, ws, lds, ctl + 128 + 16 * rep);
        else if (ph == 6 || ph == 9 || ph == 14 || ph == 17) {
            const int which = (ph == 6 || ph == 14) ? 0 : 1;
            const float* gsrc = p.in[which ? 17 : 12] + L * DM; const float* bsrc = p.in[which ? 18 : 13] + L * DM;
            if (ph == 17) ln_phase<false>(Y, Y, nullptr, nullptr, gsrc, bsrc, nullptr, nullptr, nullptr);
            else if (ph == 9) ln_phase<true>(Y, nullptr, XB, (float*)(ws + WS_STATS), gsrc, bsrc, (const float*)(ws + WS_WF), p.in[9], (float*)(ws + WS_FLOG));
            else ln_phase<false>(Y, nullptr, XB, (float*)(ws + WS_STATS), gsrc, bsrc, nullptr, nullptr, nullptr);
        }
        if (rep + 1 < nrep) xcd_barrier(xbar);
        }
        if (ph + 1 < p.hi) { if (p.hi > NPH) grid.sync(); else xcd_barrier(xbar); }
    }
}

extern "C" void kernel_launch(void* const* d_in, const int* in_sizes, int n_in, void* d_out, int out_size, void* d_ws, size_t ws_size, hipStream_t stream) {
    static int grid = 0;
    if (grid == 0) {
        if (n_in != 19 || out_size != MTOK * DM || ws_size < WS_END) { fprintf(stderr, "kernel_launch: unexpected shapes (n_in %d out %d ws %zu)\n", n_in, out_size, ws_size); grid = -1; return; }
        int dev = 0, cus = 0, per_cu = 0;
        hipGetDevice(&dev); hipDeviceGetAttribute(&cus, hipDeviceAttributeMultiprocessorCount, dev);
        hipFuncSetAttribute((const void*)mega, hipFuncAttributeMaxDynamicSharedMemorySize, LDS_BYTES);
        hipOccupancyMaxActiveBlocksPerMultiprocessor(&per_cu, (const void*)mega, 512, LDS_BYTES);
        (void)hipGetLastError();
        if (per_cu < 1) { fprintf(stderr, "kernel_launch: occupancy query says %d blocks/CU\n", per_cu); grid = -1; return; }
        grid = cus;
    }
    if (grid < 0) return;
    Params p; memset(&p, 0, sizeof(p));
    for (int i = 0; i < 19; ++i) p.in[i] = (const float*)d_in[i];
    p.out = (float*)d_out; p.ws = (unsigned char*)d_ws;
    unsigned char* ws = (unsigned char*)d_ws;
    int ns = 0, items = 0;
    auto add = [&](const float* src, const float* scale, size_t dst, int ld, int c0, int ncols, int K, int r0, int map, float cs) {
        Seg& s = p.seg[ns++]; s.src = src; s.scale = scale; s.dst = (bf16_t*)(ws + dst); s.ld = ld; s.c0 = c0; s.ncols = ncols; s.K = K; s.r0 = r0; s.map = map; s.item0 = items; s.cscale = cs;
        items += (K / 64) * ((ncols + 31) / 32);
    };
    const float* ab_w_in = p.in[1]; const float* cd_w_in = p.in[8];
    const float C8 = 0.125f * LOG2E, CMLA = 0.10206207261596577f * LOG2E;
    add(ab_w_in, nullptr, WS_WIN0, 1440, 0, 672, 1024, 0, 0, 1.f);
    add(ab_w_in, nullptr, WS_WIN0, 1440, 672, 512, 1024, 672, 0, C8);
    add(ab_w_in, nullptr, WS_WIN0, 1440, 1184, 256, 1024, 1184, 0, 1.f);
    add(nullptr, nullptr, WS_WIN0, 0, 0, 96, 1024, 1440, 0, 1.f);
    add(p.in[3], p.in[2], WS_WUQ, 768, 0, 768, 384, 0, 0, CMLA);
    add(p.in[5], p.in[4], WS_WUKV, 1024, 0, 1024, 256, 0, 0, 1.f);
    add(p.in[7], nullptr, WS_WOUT0, 1024, 0, 1024, 1024, 0, 0, 1.f);
    add(cd_w_in, nullptr, WS_WIN1, 3080, 0, 512, 1024, 0, 0, C8);
    add(cd_w_in, nullptr, WS_WIN1, 3080, 512, 1024, 1024, 512, 0, 1.f);
    add(cd_w_in, nullptr, WS_WIN1, 3080, 1544, 512, 1024, 1536, 0, C8);
    add(cd_w_in, nullptr, WS_WIN1, 3080, 2056, 1024, 1024, 2048, 0, 1.f);
    add(p.in[11], nullptr, WS_WOUT1, 1024, 0, 1024, 1024, 0, 0, 1.f);
    for (int l = 0; l < 2; ++l) {
        add(p.in[14] + (size_t)l * 1024 * DFF, nullptr, l ? WS_WGU1 : WS_WGU0, DFF, 0, DFF, 1024, 0, 1, 1.f);
        add(p.in[15] + (size_t)l * 1024 * DFF, nullptr, l ? WS_WGU1 : WS_WGU0, DFF, 0, DFF, 1024, 128, 1, 1.f);
        add(p.in[16] + (size_t)l * DFF * 1024, nullptr, l ? WS_WDN1 : WS_WDN0, 1024, 0, 1024, DFF, 0, 0, 1.f);
    }
    p.nseg = ns; p.nitems = items;
    if (hipMemsetAsync(ws + WS_CTL, 0, CTL_ZERO_BYTES, stream) != hipSuccess) { fprintf(stderr, "kernel_launch: memset failed\n"); return; }
#if ONE_LAUNCH
    p.lo = 0; p.hi = NPH;
    void* args[] = {&p};
    hipError_t e = hipLaunchCooperativeKernel((const void*)mega, dim3(grid), dim3(512), args, LDS_BYTES, stream);
    if (e != hipSuccess) fprintf(stderr, "cooperative launch failed: %s (grid %d)\n", hipGetErrorString(e), grid);
#else
    for (int ph = 0; ph < NPH; ++ph) { p.lo = ph; p.hi = ph + 1; hipLaunchKernelGGL(mega, dim3(grid), dim3(512), LDS_BYTES, stream, p); }
#endif
}
```

```cpp
#include <hip/hip_runtime.h>
#include <hip/hip_cooperative_groups.h>
#include <cstdio>
#include <cstdint>
#include <cstring>
namespace cg = cooperative_groups;

#ifndef ONE_LAUNCH
#define ONE_LAUNCH 1
#endif

#ifndef PROBE_REP
#define PROBE_REP -1
#endif
#define LAS __attribute__((address_space(3)))
typedef unsigned short bf16_t;
typedef short bf16x8 __attribute__((ext_vector_type(8)));
typedef short s16x4 __attribute__((ext_vector_type(4)));
typedef float f32x4 __attribute__((ext_vector_type(4)));
typedef float f32x16 __attribute__((ext_vector_type(16)));
typedef unsigned u32x4 __attribute__((ext_vector_type(4)));
typedef unsigned u32x2 __attribute__((ext_vector_type(2)));
typedef float f32x2_t __attribute__((ext_vector_type(2)));
typedef long i64x2 __attribute__((ext_vector_type(2)));

constexpr int BATCH = 8, SEQ = 4096, DM = 1024, MTOK = BATCH * SEQ;
constexpr int N0 = 1536;
constexpr int N1 = 3072;
constexpr int DFF = 2816;
constexpr float LN_EPS = 1e-5f, RMS_EPS = 1e-6f;
constexpr float ALPHA = 1.41421356237309515f;
constexpr float LOG2E = 1.4426950408889634f;

constexpr size_t MiB = 1u << 20;
constexpr size_t WS_CTL = 0, WS_BAR = 65536, CTL_ZERO_BYTES = 131072;
constexpr size_t WS_ROPE = 1 * MiB;
constexpr size_t WS_WIN0 = 2 * MiB, WS_WUQ = 5 * MiB, WS_WUKV = 6 * MiB, WS_WOUT0 = 7 * MiB, WS_WIN1 = 9 * MiB, WS_WOUT1 = 16 * MiB;
constexpr size_t WS_WGU0 = 18 * MiB, WS_WDN0 = 29 * MiB, WS_WGU1 = 35 * MiB, WS_WDN1 = 46 * MiB;
constexpr size_t WS_RSQ = 52 * MiB, WS_RSKV = 52 * MiB + 512 * 1024, WS_KROPE = 53 * MiB, WS_FLOG = 55 * MiB, WS_CUM = 56 * MiB;
constexpr size_t WS_WF = 58 * MiB;
constexpr size_t WS_STATS = 57 * MiB;
constexpr size_t WS_XB = 64 * MiB;
constexpr size_t WS_BIG = 128 * MiB;
constexpr size_t WS_Q = WS_BIG + 96 * MiB, WS_KV = WS_BIG + 144 * MiB;
constexpr size_t WS_O = 384 * MiB, WS_END = 448 * MiB;

constexpr int LDS_BYTES = 147456, LDS_BARW = 147456 - 64;
constexpr int NPH = 18;

__device__ __forceinline__ unsigned cvt_pk_bf16(float lo, float hi) { unsigned r; asm("v_cvt_pk_bf16_f32 %0, %1, %2" : "=v"(r) : "v"(lo), "v"(hi)); return r; }
__device__ __forceinline__ float bf_lo(unsigned u) { return __uint_as_float(u << 16); }
__device__ __forceinline__ float bf_hi(unsigned u) { return __uint_as_float(u & 0xffff0000u); }
__device__ __forceinline__ int tid_l() { int t = threadIdx.x; asm volatile("" : "+v"(t)); return t; }
__device__ __forceinline__ float half_max(float v) { auto rr = __builtin_amdgcn_permlane32_swap(__float_as_uint(v), __float_as_uint(v), false, false); return fmaxf(__uint_as_float(rr[0]), __uint_as_float(rr[1])); }
__device__ __forceinline__ float half_sum(float v) { auto rr = __builtin_amdgcn_permlane32_swap(__float_as_uint(v), __float_as_uint(v), false, false); return __uint_as_float(rr[0]) + __uint_as_float(rr[1]); }
template <int CTRL> __device__ __forceinline__ float dpp_get(float v) { return __builtin_bit_cast(float, __builtin_amdgcn_update_dpp(0, __builtin_bit_cast(int, v), CTRL, 0xF, 0xF, false)); }
__device__ __forceinline__ float wave_sum(float v) {
    v += dpp_get<0xB1>(v);
    v += dpp_get<0x4E>(v);
    v += dpp_get<0x141>(v);
    v += dpp_get<0x140>(v);
    v += __shfl_xor(v, 16);
    return half_sum(v);
}

namespace pg8 {
constexpr int BM = 256, BK = 64, HALF = 128, HTB = HALF * BK * 2, STAGE_BYTES = 8 * HTB, NXCD = 8, WGM = 8;
__device__ __forceinline__ int lds_byte(int r, int c) { const int st = (r >> 4) * 2 + (c >> 5), rr = r & 15, cc = c & 31, ob = rr * 64 + cc * 2; return st * 1024 + (ob ^ (((ob >> 9) & 1) << 5)); }
__device__ __forceinline__ void stage_rc(int b, int& R, int& C) { const int st = b / 1024, sb = b % 1024, swz = sb ^ (((sb >> 9) & 1) << 5); R = (st >> 1) * 16 + swz / 64; C = (st & 1) * 32 + (swz % 64) / 2; }
__device__ __forceinline__ int perm32(int rho) { const int n = rho >> 4, i = rho & 15; return 8 * (i >> 2) + 4 * n + (i & 3); }

struct Unit { int pm, pn; };
struct Gemm { const bf16_t* A; const bf16_t* Bt; int M, N, K, lda, ldb; };

struct StaticOrder {
    int nM, nN, nwg, G, c;
    __device__ void init(int M, int N, int G_, int c_) { nM = M / BM; nN = N / BM; nwg = nM * nN; G = G_; c = c_; }
    __device__ bool next(int i, Unit& u) const {
        const long L = (long)i * G + c; if (L >= nwg) return false;
        int wgid = (int)L; { const int q = nwg / NXCD, r = nwg % NXCD, xcd = wgid % NXCD, off = wgid / NXCD; wgid = (xcd < r ? xcd * (q + 1) : r * (q + 1) + (xcd - r) * q) + off; }
        const int nig = WGM * nN, gid = wgid / nig, fm = gid * WGM, gsz = (nM - fm) < WGM ? (nM - fm) : WGM;
        u.pm = fm + ((wgid % nig) % gsz); u.pn = (wgid % nig) / gsz; return true;
    }
};

template <int MODE>
struct Epi {
    int mode;
    bf16_t* O; int ldc; const float* rowscale; float* F32; int f32tile;
    const float* res; float* out; const float* lnstats; const float* lng; const float* lnb;
    __device__ __forceinline__ void operator()(const f32x4 (&acc)[2][2][4][2], const Unit& u, int wr, int wc, int fr, int fq) const {
        const int row0 = u.pm * BM + wr * 64 + fr;
        if (MODE == 0 || MODE == 4) {
            int colt = u.pn * BM; bf16_t* Ob = O;
            if (f32tile > 0) { const int t = colt / f32tile; Ob += (size_t)t * MTOK * f32tile; colt -= t * f32tile; }
            const int col0 = colt + wc * 32 + 8 * fq;
            float scv[2][4];
#pragma unroll
            for (int ai = 0; ai < 2; ++ai)
#pragma unroll
                for (int m = 0; m < 4; ++m) scv[ai][m] = (MODE == 4) ? rowscale[row0 + ai * HALF + m * 16] : 1.f;
#pragma unroll
            for (int ai = 0; ai < 2; ++ai)
#pragma unroll
                for (int m = 0; m < 4; ++m) {
                    const int row = row0 + ai * HALF + m * 16;
                    const float sc = scv[ai][m];
                    bf16_t* rowp = Ob + (size_t)row * ldc + col0;
#pragma unroll
                    for (int bj = 0; bj < 2; ++bj) {
                        const f32x4 v0 = acc[ai][bj][m][0] * sc, v1 = acc[ai][bj][m][1] * sc;
                        u32x4 w; w.x = cvt_pk_bf16(v0[0], v0[1]); w.y = cvt_pk_bf16(v0[2], v0[3]); w.z = cvt_pk_bf16(v1[0], v1[1]); w.w = cvt_pk_bf16(v1[2], v1[3]);
                        *(u32x4*)(rowp + bj * HALF) = w;
                    }
                }
        } else if (MODE == 1) {
            const int col0 = u.pn * HALF + wc * 32 + 8 * fq;
#pragma unroll
            for (int ai = 0; ai < 2; ++ai)
#pragma unroll
                for (int m = 0; m < 4; ++m) {
                    const int row = row0 + ai * HALF + m * 16;
                    float hv[8];
#pragma unroll
                    for (int n = 0; n < 2; ++n)
#pragma unroll
                        for (int e = 0; e < 4; ++e) { const float g = acc[ai][0][m][n][e], up = acc[ai][1][m][n][e]; hv[n * 4 + e] = g * __builtin_amdgcn_rcpf(1.f + __builtin_amdgcn_exp2f(-g * LOG2E)) * up; }
                    u32x4 w; w.x = cvt_pk_bf16(hv[0], hv[1]); w.y = cvt_pk_bf16(hv[2], hv[3]); w.z = cvt_pk_bf16(hv[4], hv[5]); w.w = cvt_pk_bf16(hv[6], hv[7]);
                    *(u32x4*)(O + (size_t)row * DFF + col0) = w;
                }
        } else {
            const int col0 = u.pn * BM + wc * 32 + 8 * fq;
            f32x4 gq[2][2], bq[2][2];
#pragma unroll
            for (int bj = 0; bj < 2; ++bj)
#pragma unroll
                for (int n = 0; n < 2; ++n) { gq[bj][n] = (MODE == 3) ? *(const f32x4*)(lng + col0 + bj * HALF + 4 * n) : (f32x4){1.f, 1.f, 1.f, 1.f}; bq[bj][n] = (MODE == 3) ? *(const f32x4*)(lnb + col0 + bj * HALF + 4 * n) : (f32x4){0.f, 0.f, 0.f, 0.f}; }
#pragma unroll
            for (int ai = 0; ai < 2; ++ai)
#pragma unroll
                for (int m = 0; m < 4; ++m) {
                    const int row = row0 + ai * HALF + m * 16;
                    const size_t off = (size_t)row * DM + col0;
                    f32x2_t st = {0.f, 1.f}; if (MODE == 3) st = *(const f32x2_t*)(lnstats + 2 * (size_t)row);
                    f32x4 rv[2][2];
#pragma unroll
                    for (int bj = 0; bj < 2; ++bj)
#pragma unroll
                        for (int n = 0; n < 2; ++n) rv[bj][n] = *(const f32x4*)(res + off + bj * HALF + 4 * n);
#pragma unroll
                    for (int bj = 0; bj < 2; ++bj)
#pragma unroll
                        for (int n = 0; n < 2; ++n) {
                            f32x4 r = rv[bj][n];
                            if (MODE == 3) r = (r - st.x) * st.y * gq[bj][n] + bq[bj][n];
                            *(f32x4*)(out + off + bj * HALF + 4 * n) = r * ALPHA + acc[ai][bj][m][n];
                        }
                }
        }
    }
};

template <class EpiT>
__device__ __forceinline__ void gemm_phase(LAS unsigned char* lds, const Gemm g, const StaticOrder& S, const EpiT& E) {
    const int tid = tid_l(), wid = __builtin_amdgcn_readfirstlane(tid >> 6), lane = tid & 63, wr = wid >> 2, wc = wid & 3, fr = lane & 15, fq = lane >> 4;
    const int K = g.K, nt = K / BK;
    unsigned voffA[2], voffB[2];
#pragma unroll
    for (int i = 0; i < 2; ++i) { int R, C; stage_rc(tid * 16 + i * 8192, R, C); const int Rb = (R & ~31) + perm32(R & 31);
        voffA[i] = (unsigned)(R * g.lda + C) * 2u; voffB[i] = (unsigned)(Rb * g.ldb + C) * 2u; }
    const size_t kstep = (size_t)(BK * 2);
    const size_t hstepA = (size_t)HALF * g.lda * 2, hstepB = (size_t)HALF * g.ldb * 2;
    const size_t tstepA = 2 * hstepA, tstepB = 2 * hstepB;
    const unsigned ldsw = (unsigned)wid * 1024u;
    const int aoff = lds_byte(wr * 64 + fr, fq * 8), boff = lds_byte(wc * 32 + fr, fq * 8);
#define PG8_SA(b, h) (((b) * 2 + (h)) * HTB)
#define PG8_SB(b, h) ((4 + (b) * 2 + (h)) * HTB)
#define PG8_STAGE(bufoff, gbase, voff) do { _Pragma("unroll") for (int _i = 0; _i < 2; ++_i) \
        __builtin_amdgcn_global_load_lds((const unsigned*)((const char*)(gbase) + (voff)[_i]), (LAS unsigned*)(lds + (bufoff) + ldsw + _i * 8192), 16, 0, 0); } while (0)
#define PG8_LDA(dst, b, h) do { _Pragma("unroll") for (int m = 0; m < 4; ++m) _Pragma("unroll") for (int k = 0; k < 2; ++k) dst[m][k] = *(const LAS bf16x8*)(lds + PG8_SA(b, h) + aoff + m * 2048 + k * 1024); } while (0)
#define PG8_LDB(dst, b, h) do { _Pragma("unroll") for (int n = 0; n < 2; ++n) _Pragma("unroll") for (int k = 0; k < 2; ++k) dst[n][k] = *(const LAS bf16x8*)(lds + PG8_SB(b, h) + boff + n * 2048 + k * 1024); } while (0)
#define PG8_MMA(ai, bj, At, Bt) do { __builtin_amdgcn_s_setprio(1); _Pragma("unroll") for (int m = 0; m < 4; ++m) _Pragma("unroll") for (int n = 0; n < 2; ++n) _Pragma("unroll") for (int k = 0; k < 2; ++k) \
        acc[ai][bj][m][n] = __builtin_amdgcn_mfma_f32_16x16x32_bf16(Bt[n][k], At[m][k], acc[ai][bj][m][n], 0, 0, 0); __builtin_amdgcn_s_setprio(0); } while (0)
#define PG8_WAIT_V(n) asm volatile("s_waitcnt vmcnt(" #n ")" ::: "memory")
#define PG8_WAIT_L(n) asm volatile("s_waitcnt lgkmcnt(" #n ")" ::: "memory")
#define PG8_BAR __builtin_amdgcn_s_barrier()
#define PG8_SCHED __builtin_amdgcn_sched_barrier(0)
    Unit cur, nxt; int ui = 0;
    if (!S.next(0, cur)) return;
    f32x4 acc[2][2][4][2];
#pragma unroll
    for (int a = 0; a < 2; ++a)
#pragma unroll
        for (int b = 0; b < 2; ++b)
#pragma unroll
            for (int m = 0; m < 4; ++m)
#pragma unroll
                for (int n = 0; n < 2; ++n) acc[a][b][m][n] = (f32x4){0.f, 0.f, 0.f, 0.f};
    bf16x8 At[4][2], B0[2][2], B1[2][2];
    const char* cA = (const char*)g.A + (size_t)cur.pm * tstepA; const char* cB = (const char*)g.Bt + (size_t)cur.pn * tstepB;
    PG8_STAGE(PG8_SB(0, 0), cB, voffB); PG8_STAGE(PG8_SB(0, 1), cB + hstepB, voffB); PG8_STAGE(PG8_SA(0, 0), cA, voffA); PG8_STAGE(PG8_SA(0, 1), cA + hstepA, voffA);
    if (wr == 1) PG8_BAR;
    PG8_WAIT_V(2); PG8_BAR;
    PG8_STAGE(PG8_SB(1, 0), cB + kstep, voffB); PG8_STAGE(PG8_SA(1, 0), cA + kstep, voffA); PG8_STAGE(PG8_SB(1, 1), cB + hstepB + kstep, voffB);
    PG8_WAIT_V(6); PG8_BAR;
    for (;;) {
        const bool has_next = S.next(ui + 1, nxt);
        const char* nA = has_next ? (const char*)g.A + (size_t)nxt.pm * tstepA : cA; const char* nB = has_next ? (const char*)g.Bt + (size_t)nxt.pn * tstepB : cB;
        for (int t = 0; t < nt; t += 2) {
            const bool last = (t == nt - 2);
            const char* a1 = cA + (size_t)(t + 1) * kstep;
            const char* a2 = last ? nA : cA + (size_t)(t + 2) * kstep; const char* b2 = last ? nB : cB + (size_t)(t + 2) * kstep;
            const char* a3 = a2 + kstep; const char* b3 = b2 + kstep;
            PG8_LDB(B0, 0, 0); PG8_LDB(B1, 0, 1); PG8_SCHED; PG8_LDA(At, 0, 0); PG8_STAGE(PG8_SA(1, 1), a1 + hstepA, voffA);
            PG8_WAIT_V(8); PG8_WAIT_L(0); PG8_BAR; PG8_MMA(0, 0, At, B0); PG8_MMA(0, 1, At, B1); PG8_BAR; PG8_SCHED;
            PG8_LDA(At, 0, 1); PG8_STAGE(PG8_SB(0, 0), b2, voffB); PG8_STAGE(PG8_SB(0, 1), b2 + hstepB, voffB); PG8_STAGE(PG8_SA(0, 0), a2, voffA);
            PG8_WAIT_V(8); PG8_WAIT_L(0); PG8_BAR; PG8_MMA(1, 0, At, B0); PG8_MMA(1, 1, At, B1); PG8_BAR; PG8_SCHED;
            PG8_LDB(B0, 1, 0); PG8_LDB(B1, 1, 1); PG8_SCHED; PG8_LDA(At, 1, 0); PG8_STAGE(PG8_SA(0, 1), a2 + hstepA, voffA);
            PG8_WAIT_V(8); PG8_WAIT_L(0); PG8_BAR; PG8_MMA(0, 0, At, B0); PG8_MMA(0, 1, At, B1); PG8_BAR; PG8_SCHED;
            PG8_LDA(At, 1, 1); PG8_STAGE(PG8_SB(1, 0), b3, voffB); PG8_STAGE(PG8_SB(1, 1), b3 + hstepB, voffB); PG8_STAGE(PG8_SA(1, 0), a3, voffA);
            PG8_WAIT_V(8); PG8_WAIT_L(0); PG8_BAR; PG8_MMA(1, 0, At, B0); PG8_MMA(1, 1, At, B1); PG8_BAR; PG8_SCHED;
        }
        if (wr == 0) PG8_BAR;
        E(acc, cur, wr, wc, fr, fq);
        if (!has_next) break;
#pragma unroll
        for (int a = 0; a < 2; ++a)
#pragma unroll
            for (int b = 0; b < 2; ++b)
#pragma unroll
                for (int m = 0; m < 4; ++m)
#pragma unroll
                    for (int n = 0; n < 2; ++n) acc[a][b][m][n] = (f32x4){0.f, 0.f, 0.f, 0.f};
        cur = nxt; cA = nA; cB = nB; ++ui;
        if (wr == 1) PG8_BAR;
    }
    PG8_WAIT_V(0);
    PG8_BAR;
#undef PG8_SA
#undef PG8_SB
#undef PG8_STAGE
#undef PG8_LDA
#undef PG8_LDB
#undef PG8_MMA
#undef PG8_WAIT_V
#undef PG8_WAIT_L
#undef PG8_BAR
#undef PG8_SCHED
}
}

struct Seg { const float* src; const float* scale; bf16_t* dst; int ld, c0, ncols, K, r0, map, item0; float cscale; };
constexpr int MAXSEG = 28;
struct Params {
    const float* in[19]; float* out; unsigned char* ws;
    int lo, hi, nseg, nitems;
    Seg seg[MAXSEG];
};

__device__ __forceinline__ void transpose_item(const Seg& s, int item, LAS float* scr, int lane) {
    const int nblk = (s.ncols + 31) / 32, kb = item / nblk, nb = item % nblk, k0 = 64 * kb, n0 = 32 * nb;
    const int c4 = 4 * (lane & 7), kr = lane >> 3;
    const bool ok = (s.src != nullptr) && (n0 + c4 + 3 < s.ncols);
    f32x4 v[8];
#pragma unroll
    for (int i = 0; i < 8; ++i) {
        v[i] = (f32x4){0.f, 0.f, 0.f, 0.f};
        if (ok) v[i] = *(const f32x4*)(s.src + (size_t)(k0 + kr + 8 * i) * s.ld + s.c0 + n0 + c4);
    }
#pragma unroll
    for (int i = 0; i < 8; ++i) {
        const int kk = kr + 8 * i;
        float sc = s.cscale; if (s.scale) sc *= s.scale[k0 + kk];
#pragma unroll
        for (int e = 0; e < 4; ++e) scr[kk * 33 + c4 + e] = v[i][e] * sc;
    }
    asm volatile("s_waitcnt lgkmcnt(0)" ::: "memory");
    const int c = lane & 7;
#pragma unroll
    for (int j = 0; j < 4; ++j) {
        const int nn = (lane >> 3) + 8 * j; const LAS float* sp = scr + (8 * c) * 33 + nn;
        u32x4 o; o.x = cvt_pk_bf16(sp[0 * 33], sp[1 * 33]); o.y = cvt_pk_bf16(sp[2 * 33], sp[3 * 33]); o.z = cvt_pk_bf16(sp[4 * 33], sp[5 * 33]); o.w = cvt_pk_bf16(sp[6 * 33], sp[7 * 33]);
        const int ncol = n0 + nn;
        const int drow = s.r0 + (s.map ? ((ncol >> 7) * 256 + (ncol & 127)) : ncol);
        *(u32x4*)(s.dst + (size_t)drow * s.K + k0 + 8 * c) = o;
    }
    asm volatile("s_waitcnt lgkmcnt(0)" ::: "memory");
}

__device__ __forceinline__ void sincos_reduced(float ang, float& c, float& s) {
    const double a = (double)ang;
    const double nq = __builtin_rint(a * 0.63661977236758134308);
    const float r = (float)(a - nq * 1.57079632679489661923);
    const int q = (int)nq & 3;
    const float r2 = r * r;
    const float sp = r + r * r2 * (-1.6666667163e-01f + r2 * (8.3333337680e-03f + r2 * (-1.9841270114e-04f + r2 * 2.7557314297e-06f)));
    const float cp = 1.f + r2 * (-0.5f + r2 * (4.1666667908e-02f + r2 * (-1.3888889225e-03f + r2 * (2.4801587642e-05f + r2 * -2.7557314297e-07f))));
    const float ss = (q & 1) ? cp : sp, cc = (q & 1) ? sp : cp;
    s = (q & 2) ? -ss : ss;
    c = ((q + 1) & 2) ? -cc : cc;
}

__device__ __forceinline__ void prologue(const Params& p, unsigned char* ws, LAS unsigned char* lds) {
    const int tid = tid_l(), lane = tid & 63, wave = tid >> 6;
    const int gw = blockIdx.x * 8 + wave, NGW = gridDim.x * 8;
    const int gt = blockIdx.x * 512 + tid, NGT = gridDim.x * 512;
    if (blockIdx.x == 0 && tid < 64) ((unsigned*)(ws + WS_CTL))[tid] = 0u;
    LAS float* scr = (LAS float*)(lds + wave * 8448);
    for (int it = gw; it < p.nitems; it += NGW) {
        int s = 0;
        while (s + 1 < p.nseg && it >= p.seg[s + 1].item0) ++s;
        transpose_item(p.seg[s], it - p.seg[s].item0, scr, lane);
    }
    const float* x = p.in[0]; bf16_t* xb = (bf16_t*)(ws + WS_XB);
    for (int i0 = gt; i0 < MTOK * DM / 8; i0 += 4 * NGT) {
        f32x4 a[4], b[4];
#pragma unroll
        for (int k = 0; k < 4; ++k) { const int i = i0 + k * NGT; if (i < MTOK * DM / 8) { a[k] = *(const f32x4*)(x + (size_t)i * 8); b[k] = *(const f32x4*)(x + (size_t)i * 8 + 4); } }
#pragma unroll
        for (int k = 0; k < 4; ++k) { const int i = i0 + k * NGT; if (i < MTOK * DM / 8) {
            u32x4 o; o.x = cvt_pk_bf16(a[k][0], a[k][1]); o.y = cvt_pk_bf16(a[k][2], a[k][3]); o.z = cvt_pk_bf16(b[k][0], b[k][1]); o.w = cvt_pk_bf16(b[k][2], b[k][3]);
            *(u32x4*)(xb + (size_t)i * 8) = o; } }
    }
    { float* wfT = (float*)(ws + WS_WF); const float* cdw = p.in[8];
      for (int i = gt; i < 8 * DM; i += NGT) { const int h = i >> 10, k = i & (DM - 1); wfT[i] = cdw[(size_t)k * 3080 + 1536 + h]; } }
    float* cosT = (float*)(ws + WS_ROPE); float* sinT = cosT + SEQ * 16;
    const float invf[16] = {1.000000000e+00f, 5.623413324e-01f, 3.162277639e-01f, 1.778279394e-01f, 1.000000015e-01f, 5.623413250e-02f, 3.162277490e-02f, 1.778279431e-02f,
                            9.999999776e-03f, 5.623413250e-03f, 3.162277630e-03f, 1.778279431e-03f, 1.000000047e-03f, 5.623413017e-04f, 3.162277571e-04f, 1.778279402e-04f};
    for (int i = gt; i < SEQ * 16; i += NGT) {
        const int pos = i >> 4, j = i & 15;
        float fr = invf[0];
#pragma unroll
        for (int k = 1; k < 16; ++k) fr = (j == k) ? invf[k] : fr;
        const float ang = (float)pos * fr;
        float c, s; sincos_reduced(ang, c, s);
        cosT[i] = c; sinT[i] = s;
    }
}

template <bool FL>
__device__ __forceinline__ void ln_phase(const float* y, float* outf, bf16_t* outb, float* stats, const float* g, const float* bt, const float* wf, const float* bforget, float* lsout) {
    const int tid = tid_l(), lane = tid & 63, wave = tid >> 6;
    const int gw = blockIdx.x * 8 + wave, NGW = gridDim.x * 8;
    f32x4 gv[4], bv[4];
#pragma unroll
    for (int j = 0; j < 4; ++j) { gv[j] = *(const f32x4*)(g + 256 * j + 4 * lane); bv[j] = *(const f32x4*)(bt + 256 * j + 4 * lane); }
    f32x4 wfr[FL ? 8 : 1][4];
    if (FL) {
#pragma unroll
        for (int h = 0; h < 8; ++h)
#pragma unroll
            for (int j = 0; j < 4; ++j) wfr[h][j] = *(const f32x4*)(wf + h * DM + 256 * j + 4 * lane);
    }
    f32x4 nx[4];
    if (gw < MTOK) {
#pragma unroll
        for (int j = 0; j < 4; ++j) nx[j] = *(const f32x4*)(y + (size_t)gw * DM + 4 * lane + 256 * j);
    }
    for (int row = gw; row < MTOK; row += NGW) {
        f32x4 v[4]; float s = 0.f;
#pragma unroll
        for (int j = 0; j < 4; ++j) { v[j] = nx[j]; s += (v[j][0] + v[j][1]) + (v[j][2] + v[j][3]); }
        if (row + NGW < MTOK) {
#pragma unroll
            for (int j = 0; j < 4; ++j) nx[j] = *(const f32x4*)(y + (size_t)(row + NGW) * DM + 4 * lane + 256 * j);
        }
        const float mean = wave_sum(s) * (1.f / DM); float s2 = 0.f;
#pragma unroll
        for (int j = 0; j < 4; ++j) { v[j] = v[j] - mean; s2 += (v[j][0] * v[j][0] + v[j][1] * v[j][1]) + (v[j][2] * v[j][2] + v[j][3] * v[j][3]); }
        const float rstd = 1.f / sqrtf(wave_sum(s2) * (1.f / DM) + LN_EPS);
        if (stats && lane == 0) { f32x2_t st = {mean, rstd}; *(f32x2_t*)(stats + 2 * (size_t)row) = st; }
        float facc[8];
#pragma unroll
        for (int h = 0; h < 8; ++h) facc[h] = 0.f;
#pragma unroll
        for (int j = 0; j < 4; ++j) {
            const f32x4 o = v[j] * rstd * gv[j] + bv[j];
            if (FL) {
#pragma unroll
                for (int h = 0; h < 8; ++h) facc[h] += (o[0] * wfr[h][j][0] + o[1] * wfr[h][j][1]) + (o[2] * wfr[h][j][2] + o[3] * wfr[h][j][3]);
            }
            if (outf) *(f32x4*)(outf + (size_t)row * DM + 256 * j + 4 * lane) = o;
            if (outb) { u32x2 w; w.x = cvt_pk_bf16(o[0], o[1]); w.y = cvt_pk_bf16(o[2], o[3]); *(u32x2*)(outb + (size_t)row * DM + 256 * j + 4 * lane) = w; }
        }
        if (FL) {
            float f4[4], f2[2], f1;
            { const bool up = (lane & 32) != 0;
#pragma unroll
              for (int i = 0; i < 4; ++i) { const float keep = up ? facc[4 + i] : facc[i], give = up ? facc[i] : facc[4 + i]; f4[i] = keep + __shfl_xor(give, 32); } }
            { const bool up = (lane & 16) != 0;
#pragma unroll
              for (int i = 0; i < 2; ++i) { const float keep = up ? f4[2 + i] : f4[i], give = up ? f4[i] : f4[2 + i]; f2[i] = keep + __shfl_xor(give, 16); } }
            { const bool up = (lane & 8) != 0; const float keep = up ? f2[1] : f2[0], give = up ? f2[0] : f2[1]; f1 = keep + __shfl_xor(give, 8); }
            f1 += __shfl_xor(f1, 4); f1 += __shfl_xor(f1, 2); f1 += __shfl_xor(f1, 1);
            if ((lane & 7) == 0) { const int h = ((lane >> 5) & 1) * 4 + ((lane >> 4) & 1) * 2 + ((lane >> 3) & 1);
                const float z = f1 + bforget[h]; lsout[(size_t)row * 8 + h] = fminf(z, 0.f) - log1pf(expf(-fabsf(z))); }
        }
    }
}

__device__ __forceinline__ void rownorm_phase(unsigned char* ws) {
    const int tid = tid_l(), lane = tid & 63, wave = tid >> 6;
    const int gw = blockIdx.x * 8 + wave, NGW = gridDim.x * 8;
    const bf16_t* proj = (const bf16_t*)(ws + WS_BIG);
    float* rsq = (float*)(ws + WS_RSQ); float* rskv = (float*)(ws + WS_RSKV);
    bf16_t* kro = (bf16_t*)(ws + WS_KROPE);
    const float* cosT = (const float*)(ws + WS_ROPE); const float* sinT = cosT + SEQ * 16;
    const int sub = lane >> 4, l16 = lane & 15;
    for (int r4 = gw * 4; r4 < MTOK; r4 += NGW * 4) {
        const int row = r4 + sub;
        const bf16_t* pr = proj + (size_t)row * N0;
        float sq = 0.f, skv = 0.f;
        u32x4 vq[3], vk[2];
#pragma unroll
        for (int i = 0; i < 3; ++i) vq[i] = *(const u32x4*)(pr + (l16 + 16 * i) * 8);
#pragma unroll
        for (int i = 0; i < 2; ++i) vk[i] = *(const u32x4*)(pr + 384 + (l16 + 16 * i) * 8);
        const float x1 = __uint_as_float((unsigned)pr[640 + l16] << 16), x2 = __uint_as_float((unsigned)pr[656 + l16] << 16);
#pragma unroll
        for (int i = 0; i < 3; ++i)
#pragma unroll
            for (int e = 0; e < 4; ++e) { const float a = bf_lo(vq[i][e]), b = bf_hi(vq[i][e]); sq += a * a + b * b; }
#pragma unroll
        for (int i = 0; i < 2; ++i)
#pragma unroll
            for (int e = 0; e < 4; ++e) { const float a = bf_lo(vk[i][e]), b = bf_hi(vk[i][e]); skv += a * a + b * b; }
#pragma unroll
        for (int o = 1; o < 16; o <<= 1) { sq += __shfl_xor(sq, o); skv += __shfl_xor(skv, o); }
        if (l16 == 0) { rsq[row] = 1.f / sqrtf(sq * (1.f / 384.f) + RMS_EPS); rskv[row] = 1.f / sqrtf(skv * (1.f / 256.f) + RMS_EPS); }
        {
            const int pos = row & (SEQ - 1);
            const float c = cosT[pos * 16 + l16], sn = sinT[pos * 16 + l16];
            const unsigned o = cvt_pk_bf16(x1 * c - x2 * sn, x1 * sn + x2 * c);
            kro[(size_t)row * 32 + l16] = (bf16_t)(o & 0xffffu); kro[(size_t)row * 32 + 16 + l16] = (bf16_t)(o >> 16);
        }
    }
}

__device__ __forceinline__ void scan_phase(const Params& p, unsigned char* ws, LAS unsigned char* lds) {
    const int tid = tid_l(), lane = tid & 63, wave = tid >> 6;
    const float* flog = (const float*)(ws + WS_FLOG); float* cum = (float*)(ws + WS_CUM);
    LAS float* wtot = (LAS float*)lds;
    for (int bh = blockIdx.x; bh < 64; bh += gridDim.x) {
        const int b = bh >> 3, h = bh & 7;
        float v[8]; float run = 0.f;
#pragma unroll
        for (int i = 0; i < 8; ++i) {
            run += flog[((size_t)b * SEQ + tid * 8 + i) * 8 + h]; v[i] = run;
        }
        float inc = run;
#pragma unroll
        for (int o = 1; o < 64; o <<= 1) { const float t = __shfl_up(inc, o); if (lane >= o) inc += t; }
        __syncthreads();
        if (lane == 63) wtot[wave] = inc;
        __syncthreads();
        float off = inc - run;
        for (int w2 = 0; w2 < wave; ++w2) off += wtot[w2];
#pragma unroll
        for (int i = 0; i < 8; ++i) cum[(size_t)bh * SEQ + tid * 8 + i] = (off + v[i]) * LOG2E;
    }
    __syncthreads();
}

constexpr int AT_KBUF = 12288, AT_NBUF = 4, AT_VOFF = AT_NBUF * AT_KBUF, AT_VBUF = 8192, AT_REL = AT_VOFF + AT_NBUF * AT_VBUF, AT_CK = AT_REL + 1280, AT_UNIT = AT_CK + AT_NBUF * 1024;
constexpr float NEG_BIG = -1e30f;
#define MX3(a, b, c) __builtin_fmaxf(__builtin_fmaxf((a), (b)), (c))
typedef __bf16 bf16x2_t __attribute__((ext_vector_type(2)));
__device__ __forceinline__ unsigned cvtpk(float lo, float hi) { f32x2_t v = {lo, hi}; bf16x2_t b = __builtin_convertvector(v, bf16x2_t); return __builtin_bit_cast(unsigned, b); }
__device__ __forceinline__ void glds16(const void* gsrc, unsigned lds_dst) { unsigned keep;
    asm volatile("s_mov_b32 %0, m0\n\ts_mov_b32 m0, %2\n\ts_nop 0\n\tglobal_load_lds_dwordx4 %1, off\n\ts_mov_b32 m0, %0" : "=&s"(keep) : "v"(gsrc), "s"(lds_dst) : "memory"); }

template <int TYPE>
__device__ __forceinline__ void attn_unit(const Params& p, unsigned char* ws, int bh, int qb, LAS unsigned char* lds) {
    constexpr int DQK = (TYPE == 0) ? 96 : 64, ND = DQK / 16;
    const int tid = tid_l(), lane = tid & 63, w = __builtin_amdgcn_readfirstlane(tid >> 6), ql = lane & 31, hi = lane >> 5;
    const int b = bh >> 3, h = (bh & 7) + ((TYPE == 1) ? (w >> 2) : 0);
    const size_t rb = (size_t)b * SEQ;
    const int q0 = (TYPE == 1) ? qb * 128 : qb * 256, qpos = q0 + 32 * ((TYPE == 1) ? (w & 3) : w) + ql;
    const bf16_t* PROJ = (const bf16_t*)(ws + WS_BIG);
    const bf16_t *Qp, *K0p, *Vp; int ldq, ldk, ocol;
    if (TYPE == 0) { Qp = (const bf16_t*)(ws + WS_Q) + h * 96; ldq = 768; K0p = (const bf16_t*)(ws + WS_KV) + h * 128; Vp = K0p + 64; ldk = 1024; ocol = h * 64; }
    else if (TYPE == 1) { Qp = PROJ + 672 + h * 64; ldq = N0; K0p = PROJ + 1184 + (h >> 2) * 64; Vp = PROJ + 1312 + (h >> 2) * 64; ldk = N0; ocol = 512 + h * 64; }
    else if (TYPE == 2) { Qp = PROJ + h * 64; ldq = 512; K0p = PROJ + (size_t)1 * MTOK * 512 + h * 64; Vp = PROJ + (size_t)2 * MTOK * 512 + h * 64; ldk = 512; ocol = h * 64; }
    else { Qp = PROJ + (size_t)3 * MTOK * 512 + h * 64; ldq = 512; K0p = PROJ + (size_t)4 * MTOK * 512 + h * 64; Vp = PROJ + (size_t)5 * MTOK * 512 + h * 64; ldk = 512; ocol = 512 + h * 64; }

    const float* cumk = (const float*)(ws + WS_CUM) + (size_t)bh * SEQ;
    const int cw = (TYPE == 1) ? 2 * qb + ((w & 3) >> 1) : 4 * qb + (w >> 1), t_hi = (TYPE == 1) ? 2 * qb + 1 : 4 * qb + 3;
    int t_lo = 0, w_lo = 0;
    if (TYPE == 1) { t_lo = max(0, 2 * qb - 2); w_lo = max(0, cw - 2); }
    if (TYPE == 3) { t_lo = max(0, 4 * qb - 8); w_lo = max(0, cw - 8); }

    const unsigned ldsb = (unsigned)(size_t)lds;
    const bf16_t* kgl = K0p + (rb + lane) * ldk + w * 8;
    const bf16_t* rgl = (const bf16_t*)(ws + WS_KROPE) + (rb + lane) * 32 + (w & 3) * 8;
    const bf16_t* vgl = Vp + (rb + 16 * (w & 3) + (lane >> 2)) * ldk + (w >> 2) * 32 + (lane & 3) * 8;
#define AT_LOADK(t, buf) do { glds16(kgl + (size_t)(t) * 64 * ldk, ldsb + (buf) * AT_KBUF + w * 1024); \
        if (TYPE == 0 && w < 4) glds16(rgl + (size_t)(t) * 64 * 32, ldsb + (buf) * AT_KBUF + (8 + w) * 1024); } while (0)
#define AT_LOADV(t, buf) do { glds16(vgl + (size_t)(t) * 64 * ldk, ldsb + AT_VOFF + (buf) * AT_VBUF + (w >> 2) * 4096 + (w & 3) * 1024); \
        if (TYPE == 2 && w == 7) glds16(cumk + (t) * 64 + lane * 4, ldsb + AT_CK + (buf) * 1024); } while (0)
#define AT_WAITBAR_FULL() do { if ((TYPE == 0 && w < 4) || (TYPE == 2 && w == 7)) asm volatile("s_waitcnt vmcnt(3) lgkmcnt(0)\n\ts_barrier" ::: "memory"); \
        else asm volatile("s_waitcnt vmcnt(2) lgkmcnt(0)\n\ts_barrier" ::: "memory"); } while (0)
#define AT_WAITBAR_ALL() asm volatile("s_waitcnt vmcnt(0) lgkmcnt(0)\n\ts_barrier" ::: "memory")

    AT_LOADK(t_lo, 0); AT_LOADV(t_lo, 0); AT_LOADK(t_lo + 1, 1); AT_LOADV(t_lo + 1, 1);
    bf16x8 qf[ND];
    {
        const bf16_t* qp = Qp + (rb + qpos) * ldq + 8 * hi;
#pragma unroll
        for (int d0 = 0; d0 < ND; ++d0) qf[d0] = *(const bf16x8*)(qp + 16 * d0);
        if (TYPE == 0) {
            const float* cosT = (const float*)(ws + WS_ROPE); const float* sinT = cosT + SEQ * 16;
            const u32x4 a = __builtin_bit_cast(u32x4, qf[4]), bq = __builtin_bit_cast(u32x4, qf[5]);
            const f32x4 c0 = *(const f32x4*)(cosT + qpos * 16 + 8 * hi), c1 = *(const f32x4*)(cosT + qpos * 16 + 8 * hi + 4);
            const f32x4 s0 = *(const f32x4*)(sinT + qpos * 16 + 8 * hi), s1 = *(const f32x4*)(sinT + qpos * 16 + 8 * hi + 4);
            u32x4 o1, o2;
#pragma unroll
            for (int e = 0; e < 4; ++e) {
                const float x1l = bf_lo(a[e]), x1h = bf_hi(a[e]), x2l = bf_lo(bq[e]), x2h = bf_hi(bq[e]);
                const float cl = (e < 2) ? c0[2 * e] : c1[2 * e - 4], ch = (e < 2) ? c0[2 * e + 1] : c1[2 * e - 3];
                const float sl = (e < 2) ? s0[2 * e] : s1[2 * e - 4], sh = (e < 2) ? s0[2 * e + 1] : s1[2 * e - 3];
                o1[e] = cvtpk(x1l * cl - x2l * sl, x1h * ch - x2h * sh);
                o2[e] = cvtpk(x1l * sl + x2l * cl, x1h * sh + x2h * ch);
            }
            qf[4] = __builtin_bit_cast(bf16x8, o1); qf[5] = __builtin_bit_cast(bf16x8, o2);
        }
    }
#pragma unroll
    for (int d0 = 0; d0 < ND; ++d0) asm volatile("" : "+v"(qf[d0]));
    float cq2 = 0.f, slope2 = 0.f, rfar = 0.f;
    if (TYPE == 2) cq2 = cumk[qpos];
    if (TYPE == 1) slope2 = __builtin_amdgcn_exp2f(-(float)(h + 1)) * LOG2E;
    LAS float* relb = (LAS float*)(lds + AT_REL);
    if (TYPE == 3) { if (tid < 320) relb[tid] = p.in[10][tid * 8 + h] * LOG2E; rfar = p.in[10][319 * 8 + h] * LOG2E; }
    asm volatile("" : "+v"(cq2), "+v"(rfar));
    const float qposf = (float)qpos;

    f32x16 oT0, oT1, negm, s0, s1;
#pragma unroll
    for (int r = 0; r < 16; ++r) { oT0[r] = 0.f; oT1[r] = 0.f; negm[r] = cq2; s0[r] = 0.f; s1[r] = 0.f; }
    float mrow = 0.f, lrow = 0.f;
    const unsigned kfrag = hi * 1024 + ql * 16;
    const unsigned vfrag = AT_VOFF + (4 * hi + ((lane & 15) >> 2)) * 64 + ((lane >> 4) & 1) * 32 + (lane & 3) * 8;
#define SBAR() __builtin_amdgcn_sched_barrier(0)

    AT_WAITBAR_ALL();
    const int npair = (t_hi - t_lo + 1) >> 1;
    for (int pp = 0; pp < npair; ++pp) {
        const int sb = (pp & 1) * 2;
        if (pp + 1 < npair) { const int tn = t_lo + 2 * pp + 2; AT_LOADK(tn, sb ^ 2); AT_LOADV(tn, sb ^ 2); AT_LOADK(tn + 1, (sb ^ 2) + 1); AT_LOADV(tn + 1, (sb ^ 2) + 1); }
#pragma unroll 1
        for (int u2 = 0; u2 < 2; ++u2) {
        const int t = t_lo + 2 * pp + u2, bc = sb + u2;
        if (t >= w_lo && t <= cw) {
            bf16x8 kf0[ND], kf1[ND];
            const LAS unsigned char* kb = lds + bc * AT_KBUF + kfrag;
#pragma unroll
            for (int d0 = 0; d0 < ND; ++d0) { kf0[d0] = *(const LAS bf16x8*)(kb + d0 * 2048); kf1[d0] = *(const LAS bf16x8*)(kb + d0 * 2048 + 512); }
            SBAR();
#pragma unroll
            for (int d0 = 0; d0 < ND; ++d0) {
                if (d0 == 0) { s0 = __builtin_amdgcn_mfma_f32_32x32x16_bf16(kf0[0], qf[0], negm, 0, 0, 0); s1 = __builtin_amdgcn_mfma_f32_32x32x16_bf16(kf1[0], qf[0], negm, 0, 0, 0); }
                else { s0 = __builtin_amdgcn_mfma_f32_32x32x16_bf16(kf0[d0], qf[d0], s0, 0, 0, 0); s1 = __builtin_amdgcn_mfma_f32_32x32x16_bf16(kf1[d0], qf[d0], s1, 0, 0, 0); }
            }
            SBAR();
            long vl0[4], vh0[4], vl1[4], vh1[4];
            const LAS unsigned char* vb = lds + bc * AT_VBUF + vfrag;
#pragma unroll
            for (int ks = 0; ks < 4; ++ks) {
                vl0[ks] = __builtin_bit_cast(long, __builtin_amdgcn_ds_read_tr16_b64_v4i16((LAS s16x4*)(vb + ks * 1024)));
                vh0[ks] = __builtin_bit_cast(long, __builtin_amdgcn_ds_read_tr16_b64_v4i16((LAS s16x4*)(vb + ks * 1024 + 512)));
                vl1[ks] = __builtin_bit_cast(long, __builtin_amdgcn_ds_read_tr16_b64_v4i16((LAS s16x4*)(vb + 4096 + ks * 1024)));
                vh1[ks] = __builtin_bit_cast(long, __builtin_amdgcn_ds_read_tr16_b64_v4i16((LAS s16x4*)(vb + 4096 + ks * 1024 + 512)));
            }
            SBAR();
            const int kbase = 64 * t + 4 * hi;
            if (TYPE == 1) {
                const float d0f = qposf - (float)kbase;
#pragma unroll
                for (int r = 0; r < 16; ++r) { const float off = (float)((r & 3) + 8 * (r >> 2));
                    s0[r] = s0[r] - slope2 * fabsf(d0f - off); s1[r] = s1[r] - slope2 * fabsf(d0f - off - 32.f); }
            } else if (TYPE == 2) {
                const LAS float* ck = (const LAS float*)(lds + AT_CK + bc * 1024) + 4 * hi;
#pragma unroll
                for (int g4 = 0; g4 < 4; ++g4) {
                    const f32x4 c0 = *(const LAS f32x4*)(ck + 8 * g4), c1 = *(const LAS f32x4*)(ck + 8 * g4 + 32);
#pragma unroll
                    for (int e = 0; e < 4; ++e) { s0[4 * g4 + e] -= c0[e]; s1[4 * g4 + e] -= c1[e]; }
                }
                if (t == cw) {
#pragma unroll
                    for (int r = 0; r < 16; ++r) { const int s = kbase + (r & 3) + 8 * (r >> 2);
                        s0[r] = (s <= qpos) ? s0[r] : NEG_BIG; s1[r] = (s + 32 <= qpos) ? s1[r] : NEG_BIG; }
                }
            } else if (TYPE == 3) {
                if (cw - t >= 5) {
#pragma unroll
                    for (int r = 0; r < 16; ++r) { s0[r] += rfar; s1[r] += rfar; }
                } else if (cw - t <= 3) {
                    const LAS float* rb2 = relb + (qpos - kbase - 28);
#pragma unroll
                    for (int r = 0; r < 16; ++r) { const int o = (r & 3) + 8 * (r >> 2); s0[r] += rb2[91 - o]; s1[r] += rb2[59 - o]; }
                } else {
                    const int dq = qpos - kbase;
#pragma unroll
                    for (int r = 0; r < 16; ++r) { const int d = dq - ((r & 3) + 8 * (r >> 2));
                        s0[r] += relb[min(d, 256) + 63]; s1[r] += relb[min(d - 32, 256) + 63]; }
                }
            }
            float ma = MX3(s0[0], s0[1], s1[0]), mb = MX3(s0[2], s0[3], s1[1]); ma = MX3(ma, s1[2], s1[3]);
#pragma unroll
            for (int r = 4; r < 16; r += 4) { ma = MX3(ma, s0[r], s0[r + 1]); mb = MX3(mb, s0[r + 2], s0[r + 3]); ma = MX3(ma, s1[r], s1[r + 1]); mb = MX3(mb, s1[r + 2], s1[r + 3]); }
            const float mx = half_max(fmaxf(ma, mb));
            if (__any(mx > 8.f)) {
                const float dl = fmaxf(mx, 0.f);
                mrow += dl;
                const float f = __builtin_amdgcn_exp2f(-dl);
                lrow *= f;
#pragma unroll
                for (int r = 0; r < 16; ++r) { s0[r] -= dl; s1[r] -= dl; negm[r] -= dl; oT0[r] *= f; oT1[r] *= f; }
            }
            float la = 0.f, lb = 0.f, lc = 0.f, ld = 0.f;
            bf16x8 pf[4];
#pragma unroll
            for (int r = 0; r < 16; r += 2) { s0[r] = __builtin_amdgcn_exp2f(s0[r]); s0[r + 1] = __builtin_amdgcn_exp2f(s0[r + 1]); la += s0[r]; lb += s0[r + 1]; }
            { u32x4 w0, w1;
              w0.x = cvtpk(s0[0], s0[1]); w0.y = cvtpk(s0[2], s0[3]); w0.z = cvtpk(s0[4], s0[5]); w0.w = cvtpk(s0[6], s0[7]);
              w1.x = cvtpk(s0[8], s0[9]); w1.y = cvtpk(s0[10], s0[11]); w1.z = cvtpk(s0[12], s0[13]); w1.w = cvtpk(s0[14], s0[15]);
              pf[0] = __builtin_bit_cast(bf16x8, w0); pf[1] = __builtin_bit_cast(bf16x8, w1); }
            SBAR();
#define AT_PV(ks) do { const bf16x8 v0_ = __builtin_bit_cast(bf16x8, (i64x2){vl0[ks], vh0[ks]}); const bf16x8 v1_ = __builtin_bit_cast(bf16x8, (i64x2){vl1[ks], vh1[ks]}); \
                oT0 = __builtin_amdgcn_mfma_f32_32x32x16_bf16(v0_, pf[ks], oT0, 0, 0, 0); oT1 = __builtin_amdgcn_mfma_f32_32x32x16_bf16(v1_, pf[ks], oT1, 0, 0, 0); } while (0)
            AT_PV(0);
            SBAR();
#pragma unroll
            for (int r = 0; r < 8; r += 2) { s1[r] = __builtin_amdgcn_exp2f(s1[r]); s1[r + 1] = __builtin_amdgcn_exp2f(s1[r + 1]); lc += s1[r]; ld += s1[r + 1]; }
            SBAR();
            AT_PV(1);
            SBAR();
#pragma unroll
            for (int r = 8; r < 16; r += 2) { s1[r] = __builtin_amdgcn_exp2f(s1[r]); s1[r + 1] = __builtin_amdgcn_exp2f(s1[r + 1]); lc += s1[r]; ld += s1[r + 1]; }
            lrow += (la + lb) + (lc + ld);
            { u32x4 w2, w3;
              w2.x = cvtpk(s1[0], s1[1]); w2.y = cvtpk(s1[2], s1[3]); w2.z = cvtpk(s1[4], s1[5]); w2.w = cvtpk(s1[6], s1[7]);
              w3.x = cvtpk(s1[8], s1[9]); w3.y = cvtpk(s1[10], s1[11]); w3.z = cvtpk(s1[12], s1[13]); w3.w = cvtpk(s1[14], s1[15]);
              pf[2] = __builtin_bit_cast(bf16x8, w2); pf[3] = __builtin_bit_cast(bf16x8, w3); }
            SBAR();
            AT_PV(2); AT_PV(3);
#undef AT_PV
            SBAR();
        }
        }
        AT_WAITBAR_ALL();
    }
#undef SBAR
#undef AT_LOADK
#undef AT_LOADV
#undef AT_WAITBAR_FULL
#undef AT_WAITBAR_ALL
    float ltot = half_sum(lrow);
    if (TYPE == 1) ltot += __builtin_amdgcn_exp2f(p.in[6][h] * LOG2E - mrow);
    const float inv = 1.f / ltot;
    bf16_t* op = (bf16_t*)(ws + WS_O) + (rb + qpos) * DM + ocol + 4 * hi;
#pragma unroll
    for (int g4 = 0; g4 < 4; ++g4) {
        u32x2 w0, w1;
        w0.x = cvtpk(oT0[4 * g4] * inv, oT0[4 * g4 + 1] * inv); w0.y = cvtpk(oT0[4 * g4 + 2] * inv, oT0[4 * g4 + 3] * inv);
        w1.x = cvtpk(oT1[4 * g4] * inv, oT1[4 * g4 + 1] * inv); w1.y = cvtpk(oT1[4 * g4 + 2] * inv, oT1[4 * g4 + 3] * inv);
        *(u32x2*)(op + 8 * g4) = w0; *(u32x2*)(op + 32 + 8 * g4) = w1;
    }
}

template <int TCAUSAL, int TBAND>
__device__ __forceinline__ void attn_phase(const Params& p, unsigned char* ws, LAS unsigned char* lds, unsigned* ctr) {
    LAS int* su = (LAS int*)(lds + AT_UNIT);
    const int tid0 = tid_l();
    __syncthreads();
    if (tid0 == 0) su[0] = (int)atomicAdd(ctr, 1u);
    __syncthreads();
    int cur = 0;
    for (;;) {
        const int u = su[cur];
        if (u >= 2048) break;
        int nxt = 0;
        if (tid0 == 0) nxt = (int)atomicAdd(ctr, 1u);
        if (u < 1024) attn_unit<TCAUSAL>(p, ws, u & 63, 15 - (u >> 6), lds);
        else if (TBAND == 1) { const int j = u - 1024; attn_unit<TBAND>(p, ws, ((j & 31) >> 2) * 8 + (j & 3) * 2, 31 - (j >> 5), lds); }
        else attn_unit<TBAND>(p, ws, (u - 1024) & 63, 15 - ((u - 1024) >> 6), lds);
        if (tid0 == 0) su[cur ^ 1] = nxt;
        __syncthreads();
        cur ^= 1;
    }
}

#define XB_TMO      128
#define XB_XCNT(j)  (256  + 64 * (j))
#define XB_XSUB(j)  (1280 + 64 * (j))
#define XB_XGEN(j)  (2304 + 64 * (j))
#define XB_TOP      3328
#define XB_TOPGEN   3392
#define XCD_BAR_WORDS 3456
#define XB_SPIN_CAP (1u << 18)
__device__ __forceinline__ unsigned xb_ld(unsigned* p)              { return __hip_atomic_load(p, __ATOMIC_RELAXED, __HIP_MEMORY_SCOPE_AGENT); }
__device__ __forceinline__ unsigned xb_add(unsigned* p, unsigned v) { return __hip_atomic_fetch_add(p, v, __ATOMIC_RELAXED, __HIP_MEMORY_SCOPE_AGENT); }
__device__ __forceinline__ unsigned xb_xcc_id() { return (unsigned)__builtin_amdgcn_s_getreg((3 << 11) | 20) & 0xFu; }
#define XB_SPIN(cond, bar) do { unsigned _sp = 0; while (cond) { __builtin_amdgcn_s_sleep(1); \
    if ((++_sp & 255u) == 0u) { if (xb_ld(&(bar)[XB_TMO])) break; if (_sp > XB_SPIN_CAP) { atomicAdd(&(bar)[XB_TMO], 1u); break; } } } } while (0)
struct XcdBarrier { unsigned* bar; unsigned x; volatile LAS unsigned* st; };
__device__ __forceinline__ XcdBarrier xcd_barrier_post(unsigned* bar, volatile LAS unsigned* st) {
    XcdBarrier b; b.bar = bar; b.x = xb_xcc_id(); b.st = st;
    if (threadIdx.x == 0) (void)xb_add(&bar[XB_XCNT(b.x)], 1u);
    return b;
}
__device__ __forceinline__ void xcd_barrier_complete(unsigned* bar, unsigned x, unsigned& nloc, unsigned& nx) {
    const unsigned G = gridDim.x * gridDim.y * gridDim.z;
    unsigned sum, cnt, mine, sp = 0u;
    for (;;) {
        sum = 0u; cnt = 0u; mine = 0u;
#pragma unroll
        for (unsigned j = 0; j < 16; ++j) { const unsigned c = xb_ld(&bar[XB_XCNT(j)]); sum += c; cnt += (c > 0u) ? 1u : 0u; mine = (j == x) ? c : mine; }
        if (sum == G) break;
        __builtin_amdgcn_s_sleep(1);
        if ((++sp & 255u) == 0u) { if (xb_ld(&bar[XB_TMO])) break; if (sp > XB_SPIN_CAP) { atomicAdd(&bar[XB_TMO], 1u); break; } }
    }
    nloc = mine > 0u ? mine : 1u; nx = cnt > 0u ? cnt : 1u;
}
__device__ __forceinline__ void xcd_barrier(const XcdBarrier& b) {
    asm volatile("s_waitcnt vmcnt(0)" ::: "memory");
    __syncthreads();
    if (threadIdx.x == 0) {
        unsigned* bar = b.bar;
        __builtin_amdgcn_s_waitcnt(0);
        unsigned nloc = b.st[0], nx = b.st[1];
        if (nloc == 0u) { xcd_barrier_complete(bar, b.x, nloc, nx); b.st[0] = nloc; b.st[1] = nx; }
        const unsigned old = xb_add(&bar[XB_XSUB(b.x)], 1u);
        const unsigned gen = old / nloc;
        if (old + 1u == (gen + 1u) * nloc) {
            __builtin_amdgcn_fence(__ATOMIC_RELEASE, "agent");
            asm volatile("s_waitcnt vmcnt(0)" ::: "memory");
            const unsigned og = xb_add(&bar[XB_TOP], 1u);
            const unsigned tg = og / nx;
            if (og + 1u == (tg + 1u) * nx) xb_add(&bar[XB_TOPGEN], 1u);
            else XB_SPIN(xb_ld(&bar[XB_TOPGEN]) == tg, bar);
            __builtin_amdgcn_fence(__ATOMIC_ACQUIRE, "agent");
            xb_add(&bar[XB_XGEN(b.x)], 1u);
            asm volatile("s_waitcnt vmcnt(0)" ::: "memory");
        } else {
            XB_SPIN(xb_ld(&bar[XB_XGEN(b.x)]) == gen, bar);
            __builtin_amdgcn_fence(__ATOMIC_ACQUIRE, "agent");
            asm volatile("s_waitcnt vmcnt(0)" ::: "memory");
        }
    }
    __syncthreads();
}

__global__ void __launch_bounds__(512, 2) mega(Params p) {
    extern __shared__ __attribute__((aligned(16))) unsigned char lds_raw[];
    LAS unsigned char* lds = (LAS unsigned char*)lds_raw;
    cg::grid_group grid = cg::this_grid();
    volatile LAS unsigned* bst = (volatile LAS unsigned*)(lds + LDS_BARW);
    if (threadIdx.x < 2) bst[threadIdx.x] = 0u;
    __syncthreads();
    XcdBarrier xbar = xcd_barrier_post((unsigned*)(p.ws + WS_BAR), bst);

    for (int ph = p.lo; ph < p.hi; ++ph) {
        if (ph == 11) continue;
        __attribute__((address_space(1))) unsigned char* gws = (__attribute__((address_space(1))) unsigned char*)p.ws;
        __attribute__((address_space(1))) float* gY = (__attribute__((address_space(1))) float*)p.out;
        asm volatile("" : "+s"(gws), "+s"(gY));
        unsigned char* ws = (unsigned char*)gws; float* Y = (float*)gY;
        bf16_t* XB = (bf16_t*)(ws + WS_XB);
        bf16_t* BIG = (bf16_t*)(ws + WS_BIG);
        bf16_t* OB = (bf16_t*)(ws + WS_O);
        unsigned* ctl = (unsigned*)(ws + WS_CTL);
        int ng = 0; pg8::Gemm g0, g1; pg8::Epi<0> e0, e1;
        e0.mode = 0; e0.O = nullptr; e0.ldc = 0; e0.rowscale = nullptr; e0.F32 = nullptr; e0.f32tile = -1; e0.res = nullptr; e0.out = nullptr; e0.lnstats = nullptr; e0.lng = nullptr; e0.lnb = nullptr; e1 = e0;
        g0.A = nullptr; g0.Bt = nullptr; g0.M = MTOK; g0.N = 0; g0.K = 0; g0.lda = 0; g0.ldb = 0; g1 = g0;
        const int L = (ph >= 10) ? 1 : 0;
        switch (ph) {
            case 1:  ng = 1; g0.A = XB; g0.lda = DM; g0.Bt = (const bf16_t*)(ws + WS_WIN0); g0.ldb = DM; g0.N = N0; g0.K = DM; e0.O = BIG; e0.ldc = N0; break;
            case 3:  ng = 2; g0.A = BIG; g0.lda = N0; g0.Bt = (const bf16_t*)(ws + WS_WUQ); g0.ldb = 384; g0.N = 768; g0.K = 384; e0.O = (bf16_t*)(ws + WS_Q); e0.ldc = 768; e0.rowscale = (const float*)(ws + WS_RSQ);
                     g1.A = BIG + 384; g1.lda = N0; g1.Bt = (const bf16_t*)(ws + WS_WUKV); g1.ldb = 256; g1.N = 1024; g1.K = 256; e1.O = (bf16_t*)(ws + WS_KV); e1.ldc = 1024; e1.rowscale = (const float*)(ws + WS_RSKV); break;
            case 5:  case 13: ng = 1; g0.A = OB; g0.lda = DM; g0.Bt = (const bf16_t*)(ws + (L ? WS_WOUT1 : WS_WOUT0)); g0.ldb = DM; g0.N = DM; g0.K = DM; e0.mode = 2; e0.res = (ph == 5) ? p.in[0] : Y; e0.out = Y;
                     if (ph == 13) { e0.lnstats = (const float*)(ws + WS_STATS); e0.lng = p.in[17]; e0.lnb = p.in[18]; } break;
            case 7:  case 15: ng = 1; g0.A = XB; g0.lda = DM; g0.Bt = (const bf16_t*)(ws + (L ? WS_WGU1 : WS_WGU0)); g0.ldb = DM; g0.N = 2 * DFF; g0.K = DM; e0.mode = 1; e0.O = BIG; break;
            case 8:  case 16: ng = 1; g0.A = BIG; g0.lda = DFF; g0.Bt = (const bf16_t*)(ws + (L ? WS_WDN1 : WS_WDN0)); g0.ldb = DFF; g0.N = DM; g0.K = DFF; e0.mode = 2; e0.res = Y; e0.out = Y; e0.lnstats = (const float*)(ws + WS_STATS); e0.lng = p.in[12] + L * DM; e0.lnb = p.in[13] + L * DM; break;
            case 10: ng = 1; g0.A = XB; g0.lda = DM; g0.Bt = (const bf16_t*)(ws + WS_WIN1); g0.ldb = DM; g0.N = N1; g0.K = DM; e0.O = BIG; e0.ldc = 512; e0.f32tile = 512; break;
            default: break;
        }
        const int nrep = (ph == PROBE_REP) ? 2 : 1;
        for (int rep = 0; rep < nrep; ++rep) {
        if (ph == 10) scan_phase(p, ws, lds);
        for (int j = 0; j < ng; ++j) {
            const pg8::Gemm gg = j ? g1 : g0; const pg8::Epi<0> ee = j ? e1 : e0;
            pg8::StaticOrder S; S.init(gg.M, gg.N, (int)gridDim.x, (int)blockIdx.x);
#define EPI_COPY(T, x) pg8::Epi<T> x; x.mode = ee.mode; x.O = ee.O; x.ldc = ee.ldc; x.rowscale = ee.rowscale; x.F32 = ee.F32; x.f32tile = ee.f32tile; x.res = ee.res; x.out = ee.out; x.lnstats = ee.lnstats; x.lng = ee.lng; x.lnb = ee.lnb
            if (ee.mode == 0 && ee.rowscale == nullptr) pg8::gemm_phase(lds, gg, S, ee);
            else if (ee.mode == 0) { EPI_COPY(4, e4t); pg8::gemm_phase(lds, gg, S, e4t); }
            else if (ee.mode == 1) { EPI_COPY(1, e1t); pg8::gemm_phase(lds, gg, S, e1t); }
            else if (ee.lnstats == nullptr) { EPI_COPY(2, e2t); pg8::gemm_phase(lds, gg, S, e2t); }
            else { EPI_COPY(3, e3t); pg8::gemm_phase(lds, gg, S, e3t); }
#undef EPI_COPY
        }
        if (ph == 0) prologue(p, ws, lds);
        else if (ph == 2) rownorm_phase(ws);
        else if (ph == 4) attn_phase<0, 1>(p, ws, lds, ctl + 0 + 2 * rep);
        else if (ph == 12) attn_phase<2, 3>(p, ws, lds, ctl + 1 + 2 * rep);
        else if (ph == 6 || ph == 9 || ph == 14 || ph == 17) {
            const int which = (ph == 6 || ph == 14) ? 0 : 1;
            const float* gsrc = p.in[which ? 17 : 12] + L * DM; const float* bsrc = p.in[which ? 18 : 13] + L * DM;
            if (ph == 17) ln_phase<false>(Y, Y, nullptr, nullptr, gsrc, bsrc, nullptr, nullptr, nullptr);
            else if (ph == 9) ln_phase<true>(Y, nullptr, XB, (float*)(ws + WS_STATS), gsrc, bsrc, (const float*)(ws + WS_WF), p.in[9], (float*)(ws + WS_FLOG));
            else ln_phase<false>(Y, nullptr, XB, (float*)(ws + WS_STATS), gsrc, bsrc, nullptr, nullptr, nullptr);
        }
        if (rep + 1 < nrep) xcd_barrier(xbar);
        }
        if (ph + 1 < p.hi) { if (p.hi > NPH) grid.sync(); else xcd_barrier(xbar); }
    }
}

extern "C" void kernel_launch(void* const* d_in, const int* in_sizes, int n_in, void* d_out, int out_size, void* d_ws, size_t ws_size, hipStream_t stream) {
    static int grid = 0;
    if (grid == 0) {
        if (n_in != 19 || out_size != MTOK * DM || ws_size < WS_END) { fprintf(stderr, "kernel_launch: unexpected shapes (n_in %d out %d ws %zu)\n", n_in, out_size, ws_size); grid = -1; return; }
        int dev = 0, cus = 0, per_cu = 0;
        hipGetDevice(&dev); hipDeviceGetAttribute(&cus, hipDeviceAttributeMultiprocessorCount, dev);
        hipFuncSetAttribute((const void*)mega, hipFuncAttributeMaxDynamicSharedMemorySize, LDS_BYTES);
        hipOccupancyMaxActiveBlocksPerMultiprocessor(&per_cu, (const void*)mega, 512, LDS_BYTES);
        (void)hipGetLastError();
        if (per_cu < 1) { fprintf(stderr, "kernel_launch: occupancy query says %d blocks/CU\n", per_cu); grid = -1; return; }
        grid = cus;
    }
    if (grid < 0) return;
    Params p; memset(&p, 0, sizeof(p));
    for (int i = 0; i < 19; ++i) p.in[i] = (const float*)d_in[i];
    p.out = (float*)d_out; p.ws = (unsigned char*)d_ws;
    unsigned char* ws = (unsigned char*)d_ws;
    int ns = 0, items = 0;
    auto add = [&](const float* src, const float* scale, size_t dst, int ld, int c0, int ncols, int K, int r0, int map, float cs) {
        Seg& s = p.seg[ns++]; s.src = src; s.scale = scale; s.dst = (bf16_t*)(ws + dst); s.ld = ld; s.c0 = c0; s.ncols = ncols; s.K = K; s.r0 = r0; s.map = map; s.item0 = items; s.cscale = cs;
        items += (K / 64) * ((ncols + 31) / 32);
    };
    const float* ab_w_in = p.in[1]; const float* cd_w_in = p.in[8];
    const float C8 = 0.125f * LOG2E, CMLA = 0.10206207261596577f * LOG2E;
    add(ab_w_in, nullptr, WS_WIN0, 1440, 0, 672, 1024, 0, 0, 1.f);
    add(ab_w_in, nullptr, WS_WIN0, 1440, 672, 512, 1024, 672, 0, C8);
    add(ab_w_in, nullptr, WS_WIN0, 1440, 1184, 256, 1024, 1184, 0, 1.f);
    add(nullptr, nullptr, WS_WIN0, 0, 0, 96, 1024, 1440, 0, 1.f);
    add(p.in[3], p.in[2], WS_WUQ, 768, 0, 768, 384, 0, 0, CMLA);
    add(p.in[5], p.in[4], WS_WUKV, 1024, 0, 1024, 256, 0, 0, 1.f);
    add(p.in[7], nullptr, WS_WOUT0, 1024, 0, 1024, 1024, 0, 0, 1.f);
    add(cd_w_in, nullptr, WS_WIN1, 3080, 0, 512, 1024, 0, 0, C8);
    add(cd_w_in, nullptr, WS_WIN1, 3080, 512, 1024, 1024, 512, 0, 1.f);
    add(cd_w_in, nullptr, WS_WIN1, 3080, 1544, 512, 1024, 1536, 0, C8);
    add(cd_w_in, nullptr, WS_WIN1, 3080, 2056, 1024, 1024, 2048, 0, 1.f);
    add(p.in[11], nullptr, WS_WOUT1, 1024, 0, 1024, 1024, 0, 0, 1.f);
    for (int l = 0; l < 2; ++l) {
        add(p.in[14] + (size_t)l * 1024 * DFF, nullptr, l ? WS_WGU1 : WS_WGU0, DFF, 0, DFF, 1024, 0, 1, 1.f);
        add(p.in[15] + (size_t)l * 1024 * DFF, nullptr, l ? WS_WGU1 : WS_WGU0, DFF, 0, DFF, 1024, 128, 1, 1.f);
        add(p.in[16] + (size_t)l * DFF * 1024, nullptr, l ? WS_WDN1 : WS_WDN0, 1024, 0, 1024, DFF, 0, 0, 1.f);
    }
    p.nseg = ns; p.nitems = items;
    if (hipMemsetAsync(ws + WS_CTL, 0, CTL_ZERO_BYTES, stream) != hipSuccess) { fprintf(stderr, "kernel_launch: memset failed\n"); return; }
#if ONE_LAUNCH
    p.lo = 0; p.hi = NPH;
    void* args[] = {&p};
    hipError_t e = hipLaunchCooperativeKernel((const void*)mega, dim3(grid), dim3(512), args, LDS_BYTES, stream);
    if (e != hipSuccess) fprintf(stderr, "cooperative launch failed: %s (grid %d)\n", hipGetErrorString(e), grid);
#else
    for (int ph = 0; ph < NPH; ++ph) { p.lo = ph; p.hi = ph + 1; hipLaunchKernelGGL(mega, dim3(grid), dim3(512), LDS_BYTES, stream, p); }
#endif
}
```

```cpp
#include <hip/hip_runtime.h>
#include <hip/hip_cooperative_groups.h>
#include <cstdio>
#include <cstdint>
#include <cstring>
namespace cg = cooperative_groups;

#ifndef ONE_LAUNCH
#define ONE_LAUNCH 1
#endif

#ifndef PROBE_REP
#define PROBE_REP -1
#endif
#define LAS __attribute__((address_space(3)))
typedef unsigned short bf16_t;
typedef short bf16x8 __attribute__((ext_vector_type(8)));
typedef short s16x4 __attribute__((ext_vector_type(4)));
typedef float f32x4 __attribute__((ext_vector_type(4)));
typedef float f32x16 __attribute__((ext_vector_type(16)));
typedef unsigned u32x4 __attribute__((ext_vector_type(4)));
typedef unsigned u32x2 __attribute__((ext_vector_type(2)));
typedef float f32x2_t __attribute__((ext_vector_type(2)));
typedef long i64x2 __attribute__((ext_vector_type(2)));

constexpr int BATCH = 8, SEQ = 4096, DM = 1024, MTOK = BATCH * SEQ;
constexpr int N0 = 1536;
constexpr int N1 = 3072;
constexpr int DFF = 2816;
constexpr float LN_EPS = 1e-5f, RMS_EPS = 1e-6f;
constexpr float ALPHA = 1.41421356237309515f;
constexpr float LOG2E = 1.4426950408889634f;

constexpr size_t MiB = 1u << 20;
constexpr size_t WS_CTL = 0, WS_BAR = 65536, CTL_ZERO_BYTES = 131072;
constexpr size_t WS_ROPE = 1 * MiB;
constexpr size_t WS_WIN0 = 2 * MiB, WS_WUQ = 5 * MiB, WS_WUKV = 6 * MiB, WS_WOUT0 = 7 * MiB, WS_WIN1 = 9 * MiB, WS_WOUT1 = 16 * MiB;
constexpr size_t WS_WGU0 = 18 * MiB, WS_WDN0 = 29 * MiB, WS_WGU1 = 35 * MiB, WS_WDN1 = 46 * MiB;
constexpr size_t WS_RSQ = 52 * MiB, WS_RSKV = 52 * MiB + 512 * 1024, WS_KROPE = 53 * MiB, WS_FLOG = 55 * MiB, WS_CUM = 56 * MiB;
constexpr size_t WS_WF = 58 * MiB;
constexpr size_t WS_STATS = 57 * MiB;
constexpr size_t WS_XB = 64 * MiB;
constexpr size_t WS_BIG = 128 * MiB;
constexpr size_t WS_Q = WS_BIG + 96 * MiB, WS_KV = WS_BIG + 144 * MiB;
constexpr size_t WS_O = 384 * MiB, WS_END = 448 * MiB;

constexpr int LDS_BYTES = 147456, LDS_BARW = 147456 - 64;
constexpr int NPH = 18;

__device__ __forceinline__ unsigned cvt_pk_bf16(float lo, float hi) { unsigned r; asm("v_cvt_pk_bf16_f32 %0, %1, %2" : "=v"(r) : "v"(lo), "v"(hi)); return r; }
__device__ __forceinline__ float bf_lo(unsigned u) { return __uint_as_float(u << 16); }
__device__ __forceinline__ float bf_hi(unsigned u) { return __uint_as_float(u & 0xffff0000u); }
__device__ __forceinline__ int tid_l() { int t = threadIdx.x; asm volatile("" : "+v"(t)); return t; }
__device__ __forceinline__ float half_max(float v) { auto rr = __builtin_amdgcn_permlane32_swap(__float_as_uint(v), __float_as_uint(v), false, false); return fmaxf(__uint_as_float(rr[0]), __uint_as_float(rr[1])); }
__device__ __forceinline__ float half_sum(float v) { auto rr = __builtin_amdgcn_permlane32_swap(__float_as_uint(v), __float_as_uint(v), false, false); return __uint_as_float(rr[0]) + __uint_as_float(rr[1]); }
template <int CTRL> __device__ __forceinline__ float dpp_get(float v) { return __builtin_bit_cast(float, __builtin_amdgcn_update_dpp(0, __builtin_bit_cast(int, v), CTRL, 0xF, 0xF, false)); }
__device__ __forceinline__ float wave_sum(float v) {
    v += dpp_get<0xB1>(v);
    v += dpp_get<0x4E>(v);
    v += dpp_get<0x141>(v);
    v += dpp_get<0x140>(v);
    v += __shfl_xor(v, 16);
    return half_sum(v);
}

namespace pg8 {
constexpr int BM = 256, BK = 64, HALF = 128, HTB = HALF * BK * 2, STAGE_BYTES = 8 * HTB, NXCD = 8, WGM = 8;
__device__ __forceinline__ int lds_byte(int r, int c) { const int st = (r >> 4) * 2 + (c >> 5), rr = r & 15, cc = c & 31, ob = rr * 64 + cc * 2; return st * 1024 + (ob ^ (((ob >> 9) & 1) << 5)); }
__device__ __forceinline__ void stage_rc(int b, int& R, int& C) { const int st = b / 1024, sb = b % 1024, swz = sb ^ (((sb >> 9) & 1) << 5); R = (st >> 1) * 16 + swz / 64; C = (st & 1) * 32 + (swz % 64) / 2; }
__device__ __forceinline__ int perm32(int rho) { const int n = rho >> 4, i = rho & 15; return 8 * (i >> 2) + 4 * n + (i & 3); }

struct Unit { int pm, pn; };
struct Gemm { const bf16_t* A; const bf16_t* Bt; int M, N, K, lda, ldb; };

struct StaticOrder {
    int nM, nN, nwg, G, c;
    __device__ void init(int M, int N, int G_, int c_) { nM = M / BM; nN = N / BM; nwg = nM * nN; G = G_; c = c_; }
    __device__ bool next(int i, Unit& u) const {
        const long L = (long)i * G + c; if (L >= nwg) return false;
        int wgid = (int)L; { const int q = nwg / NXCD, r = nwg % NXCD, xcd = wgid % NXCD, off = wgid / NXCD; wgid = (xcd < r ? xcd * (q + 1) : r * (q + 1) + (xcd - r) * q) + off; }
        const int nig = WGM * nN, gid = wgid / nig, fm = gid * WGM, gsz = (nM - fm) < WGM ? (nM - fm) : WGM;
        u.pm = fm + ((wgid % nig) % gsz); u.pn = (wgid % nig) / gsz; return true;
    }
};

template <int MODE>
struct Epi {
    int mode;
    bf16_t* O; int ldc; const float* rowscale; float* F32; int f32tile;
    const float* res; float* out; const float* lnstats; const float* lng; const float* lnb;
    __device__ __forceinline__ void operator()(const f32x4 (&acc)[2][2][4][2], const Unit& u, int wr, int wc, int fr, int fq) const {
        const int row0 = u.pm * BM + wr * 64 + fr;
        if (MODE == 0 || MODE == 4) {
            int colt = u.pn * BM; bf16_t* Ob = O;
            if (f32tile > 0) { const int t = colt / f32tile; Ob += (size_t)t * MTOK * f32tile; colt -= t * f32tile; }
            const int col0 = colt + wc * 32 + 8 * fq;
            float scv[2][4];
#pragma unroll
            for (int ai = 0; ai < 2; ++ai)
#pragma unroll
                for (int m = 0; m < 4; ++m) scv[ai][m] = (MODE == 4) ? rowscale[row0 + ai * HALF + m * 16] : 1.f;
#pragma unroll
            for (int ai = 0; ai < 2; ++ai)
#pragma unroll
                for (int m = 0; m < 4; ++m) {
                    const int row = row0 + ai * HALF + m * 16;
                    const float sc = scv[ai][m];
                    bf16_t* rowp = Ob + (size_t)row * ldc + col0;
#pragma unroll
                    for (int bj = 0; bj < 2; ++bj) {
                        const f32x4 v0 = acc[ai][bj][m][0] * sc, v1 = acc[ai][bj][m][1] * sc;
                        u32x4 w; w.x = cvt_pk_bf16(v0[0], v0[1]); w.y = cvt_pk_bf16(v0[2], v0[3]); w.z = cvt_pk_bf16(v1[0], v1[1]); w.w = cvt_pk_bf16(v1[2], v1[3]);
                        *(u32x4*)(rowp + bj * HALF) = w;
                    }
                }
        } else if (MODE == 1) {
            const int col0 = u.pn * HALF + wc * 32 + 8 * fq;
#pragma unroll
            for (int ai = 0; ai < 2; ++ai)
#pragma unroll
                for (int m = 0; m < 4; ++m) {
                    const int row = row0 + ai * HALF + m * 16;
                    float hv[8];
#pragma unroll
                    for (int n = 0; n < 2; ++n)
#pragma unroll
                        for (int e = 0; e < 4; ++e) { const float g = acc[ai][0][m][n][e], up = acc[ai][1][m][n][e]; hv[n * 4 + e] = g * __builtin_amdgcn_rcpf(1.f + __builtin_amdgcn_exp2f(-g * LOG2E)) * up; }
                    u32x4 w; w.x = cvt_pk_bf16(hv[0], hv[1]); w.y = cvt_pk_bf16(hv[2], hv[3]); w.z = cvt_pk_bf16(hv[4], hv[5]); w.w = cvt_pk_bf16(hv[6], hv[7]);
                    *(u32x4*)(O + (size_t)row * DFF + col0) = w;
                }
        } else {
            const int col0 = u.pn * BM + wc * 32 + 8 * fq;
            f32x4 gq[2][2], bq[2][2];
#pragma unroll
            for (int bj = 0; bj < 2; ++bj)
#pragma unroll
                for (int n = 0; n < 2; ++n) { gq[bj][n] = (MODE == 3) ? *(const f32x4*)(lng + col0 + bj * HALF + 4 * n) : (f32x4){1.f, 1.f, 1.f, 1.f}; bq[bj][n] = (MODE == 3) ? *(const f32x4*)(lnb + col0 + bj * HALF + 4 * n) : (f32x4){0.f, 0.f, 0.f, 0.f}; }
#pragma unroll
            for (int ai = 0; ai < 2; ++ai)
#pragma unroll
                for (int m = 0; m < 4; ++m) {
                    const int row = row0 + ai * HALF + m * 16;
                    const size_t off = (size_t)row * DM + col0;
                    f32x2_t st = {0.f, 1.f}; if (MODE == 3) st = *(const f32x2_t*)(lnstats + 2 * (size_t)row);
                    f32x4 rv[2][2];
#pragma unroll
                    for (int bj = 0; bj < 2; ++bj)
#pragma unroll
                        for (int n = 0; n < 2; ++n) rv[bj][n] = *(const f32x4*)(res + off + bj * HALF + 4 * n);
#pragma unroll
                    for (int bj = 0; bj < 2; ++bj)
#pragma unroll
                        for (int n = 0; n < 2; ++n) {
                            f32x4 r = rv[bj][n];
                            if (MODE == 3) r = (r - st.x) * st.y * gq[bj][n] + bq[bj][n];
                            *(f32x4*)(out + off + bj * HALF + 4 * n) = r * ALPHA + acc[ai][bj][m][n];
                        }
                }
        }
    }
};

template <class EpiT>
__device__ __forceinline__ void gemm_phase(LAS unsigned char* lds, const Gemm g, const StaticOrder& S, const EpiT& E) {
    const int tid = tid_l(), wid = __builtin_amdgcn_readfirstlane(tid >> 6), lane = tid & 63, wr = wid >> 2, wc = wid & 3, fr = lane & 15, fq = lane >> 4;
    const int K = g.K, nt = K / BK;
    unsigned voffA[2], voffB[2];
#pragma unroll
    for (int i = 0; i < 2; ++i) { int R, C; stage_rc(tid * 16 + i * 8192, R, C); const int Rb = (R & ~31) + perm32(R & 31);
        voffA[i] = (unsigned)(R * g.lda + C) * 2u; voffB[i] = (unsigned)(Rb * g.ldb + C) * 2u; }
    const size_t kstep = (size_t)(BK * 2);
    const size_t hstepA = (size_t)HALF * g.lda * 2, hstepB = (size_t)HALF * g.ldb * 2;
    const size_t tstepA = 2 * hstepA, tstepB = 2 * hstepB;
    const unsigned ldsw = (unsigned)wid * 1024u;
    const int aoff = lds_byte(wr * 64 + fr, fq * 8), boff = lds_byte(wc * 32 + fr, fq * 8);
#define PG8_SA(b, h) (((b) * 2 + (h)) * HTB)
#define PG8_SB(b, h) ((4 + (b) * 2 + (h)) * HTB)
#define PG8_STAGE(bufoff, gbase, voff) do { _Pragma("unroll") for (int _i = 0; _i < 2; ++_i) \
        __builtin_amdgcn_global_load_lds((const unsigned*)((const char*)(gbase) + (voff)[_i]), (LAS unsigned*)(lds + (bufoff) + ldsw + _i * 8192), 16, 0, 0); } while (0)
#define PG8_LDA(dst, b, h) do { _Pragma("unroll") for (int m = 0; m < 4; ++m) _Pragma("unroll") for (int k = 0; k < 2; ++k) dst[m][k] = *(const LAS bf16x8*)(lds + PG8_SA(b, h) + aoff + m * 2048 + k * 1024); } while (0)
#define PG8_LDB(dst, b, h) do { _Pragma("unroll") for (int n = 0; n < 2; ++n) _Pragma("unroll") for (int k = 0; k < 2; ++k) dst[n][k] = *(const LAS bf16x8*)(lds + PG8_SB(b, h) + boff + n * 2048 + k * 1024); } while (0)
#define PG8_MMA(ai, bj, At, Bt) do { __builtin_amdgcn_s_setprio(1); _Pragma("unroll") for (int m = 0; m < 4; ++m) _Pragma("unroll") for (int n = 0; n < 2; ++n) _Pragma("unroll") for (int k = 0; k < 2; ++k) \
        acc[ai][bj][m][n] = __builtin_amdgcn_mfma_f32_16x16x32_bf16(Bt[n][k], At[m][k], acc[ai][bj][m][n], 0, 0, 0); __builtin_amdgcn_s_setprio(0); } while (0)
#define PG8_WAIT_V(n) asm volatile("s_waitcnt vmcnt(" #n ")" ::: "memory")
#define PG8_WAIT_L(n) asm volatile("s_waitcnt lgkmcnt(" #n ")" ::: "memory")
#define PG8_BAR __builtin_amdgcn_s_barrier()
#define PG8_SCHED __builtin_amdgcn_sched_barrier(0)
    Unit cur, nxt; int ui = 0;
    if (!S.next(0, cur)) return;
    f32x4 acc[2][2][4][2];
#pragma unroll
    for (int a = 0; a < 2; ++a)
#pragma unroll
        for (int b = 0; b < 2; ++b)
#pragma unroll
            for (int m = 0; m < 4; ++m)
#pragma unroll
                for (int n = 0; n < 2; ++n) acc[a][b][m][n] = (f32x4){0.f, 0.f, 0.f, 0.f};
    bf16x8 At[4][2], B0[2][2], B1[2][2];
    const char* cA = (const char*)g.A + (size_t)cur.pm * tstepA; const char* cB = (const char*)g.Bt + (size_t)cur.pn * tstepB;
    PG8_STAGE(PG8_SB(0, 0), cB, voffB); PG8_STAGE(PG8_SB(0, 1), cB + hstepB, voffB); PG8_STAGE(PG8_SA(0, 0), cA, voffA); PG8_STAGE(PG8_SA(0, 1), cA + hstepA, voffA);
    if (wr == 1) PG8_BAR;
    PG8_WAIT_V(2); PG8_BAR;
    PG8_STAGE(PG8_SB(1, 0), cB + kstep, voffB); PG8_STAGE(PG8_SA(1, 0), cA + kstep, voffA); PG8_STAGE(PG8_SB(1, 1), cB + hstepB + kstep, voffB);
    PG8_WAIT_V(6); PG8_BAR;
    for (;;) {
        const bool has_next = S.next(ui + 1, nxt);
        const char* nA = has_next ? (const char*)g.A + (size_t)nxt.pm * tstepA : cA; const char* nB = has_next ? (const char*)g.Bt + (size_t)nxt.pn * tstepB : cB;
        for (int t = 0; t < nt; t += 2) {
            const bool last = (t == nt - 2);
            const char* a1 = cA + (size_t)(t + 1) * kstep;
            const char* a2 = last ? nA : cA + (size_t)(t + 2) * kstep; const char* b2 = last ? nB : cB + (size_t)(t + 2) * kstep;
            const char* a3 = a2 + kstep; const char* b3 = b2 + kstep;
            PG8_LDB(B0, 0, 0); PG8_LDB(B1, 0, 1); PG8_SCHED; PG8_LDA(At, 0, 0); PG8_STAGE(PG8_SA(1, 1), a1 + hstepA, voffA);
            PG8_WAIT_V(8); PG8_WAIT_L(0); PG8_BAR; PG8_MMA(0, 0, At, B0); PG8_MMA(0, 1, At, B1); PG8_BAR; PG8_SCHED;
            PG8_LDA(At, 0, 1); PG8_STAGE(PG8_SB(0, 0), b2, voffB); PG8_STAGE(PG8_SB(0, 1), b2 + hstepB, voffB); PG8_STAGE(PG8_SA(0, 0), a2, voffA);
            PG8_WAIT_V(8); PG8_WAIT_L(0); PG8_BAR; PG8_MMA(1, 0, At, B0); PG8_MMA(1, 1, At, B1); PG8_BAR; PG8_SCHED;
            PG8_LDB(B0, 1, 0); PG8_LDB(B1, 1, 1); PG8_SCHED; PG8_LDA(At, 1, 0); PG8_STAGE(PG8_SA(0, 1), a2 + hstepA, voffA);
            PG8_WAIT_V(8); PG8_WAIT_L(0); PG8_BAR; PG8_MMA(0, 0, At, B0); PG8_MMA(0, 1, At, B1); PG8_BAR; PG8_SCHED;
            PG8_LDA(At, 1, 1); PG8_STAGE(PG8_SB(1, 0), b3, voffB); PG8_STAGE(PG8_SB(1, 1), b3 + hstepB, voffB); PG8_STAGE(PG8_SA(1, 0), a3, voffA);
            PG8_WAIT_V(8); PG8_WAIT_L(0); PG8_BAR; PG8_MMA(1, 0, At, B0); PG8_MMA(1, 1, At, B1); PG8_BAR; PG8_SCHED;
        }
        if (wr == 0) PG8_BAR;
        E(acc, cur, wr, wc, fr, fq);
        if (!has_next) break;
#pragma unroll
        for (int a = 0; a < 2; ++a)
#pragma unroll
            for (int b = 0; b < 2; ++b)
#pragma unroll
                for (int m = 0; m < 4; ++m)
#pragma unroll
                    for (int n = 0; n < 2; ++n) acc[a][b][m][n] = (f32x4){0.f, 0.f, 0.f, 0.f};
        cur = nxt; cA = nA; cB = nB; ++ui;
        if (wr == 1) PG8_BAR;
    }
    PG8_WAIT_V(0);
    PG8_BAR;
#undef PG8_SA
#undef PG8_SB
#undef PG8_STAGE
#undef PG8_LDA
#undef PG8_LDB
#undef PG8_MMA
#undef PG8_WAIT_V
#undef PG8_WAIT_L
#undef PG8_BAR
#undef PG8_SCHED
}
}

struct Seg { const float* src; const float* scale; bf16_t* dst; int ld, c0, ncols, K, r0, map, item0; float cscale; };
constexpr int MAXSEG = 28;
struct Params {
    const float* in[19]; float* out; unsigned char* ws;
    int lo, hi, nseg, nitems;
    Seg seg[MAXSEG];
};

__device__ __forceinline__ void transpose_item(const Seg& s, int item, LAS float* scr, int lane) {
    const int nblk = (s.ncols + 31) / 32, kb = item / nblk, nb = item % nblk, k0 = 64 * kb, n0 = 32 * nb;
    const int c4 = 4 * (lane & 7), kr = lane >> 3;
    const bool ok = (s.src != nullptr) && (n0 + c4 + 3 < s.ncols);
    f32x4 v[8];
#pragma unroll
    for (int i = 0; i < 8; ++i) {
        v[i] = (f32x4){0.f, 0.f, 0.f, 0.f};
        if (ok) v[i] = *(const f32x4*)(s.src + (size_t)(k0 + kr + 8 * i) * s.ld + s.c0 + n0 + c4);
    }
#pragma unroll
    for (int i = 0; i < 8; ++i) {
        const int kk = kr + 8 * i;
        float sc = s.cscale; if (s.scale) sc *= s.scale[k0 + kk];
#pragma unroll
        for (int e = 0; e < 4; ++e) scr[kk * 33 + c4 + e] = v[i][e] * sc;
    }
    asm volatile("s_waitcnt lgkmcnt(0)" ::: "memory");
    const int c = lane & 7;
#pragma unroll
    for (int j = 0; j < 4; ++j) {
        const int nn = (lane >> 3) + 8 * j; const LAS float* sp = scr + (8 * c) * 33 + nn;
        u32x4 o; o.x = cvt_pk_bf16(sp[0 * 33], sp[1 * 33]); o.y = cvt_pk_bf16(sp[2 * 33], sp[3 * 33]); o.z = cvt_pk_bf16(sp[4 * 33], sp[5 * 33]); o.w = cvt_pk_bf16(sp[6 * 33], sp[7 * 33]);
        const int ncol = n0 + nn;
        const int drow = s.r0 + (s.map ? ((ncol >> 7) * 256 + (ncol & 127)) : ncol);
        *(u32x4*)(s.dst + (size_t)drow * s.K + k0 + 8 * c) = o;
    }
    asm volatile("s_waitcnt lgkmcnt(0)" ::: "memory");
}

__device__ __forceinline__ void sincos_reduced(float ang, float& c, float& s) {
    const double a = (double)ang;
    const double nq = __builtin_rint(a * 0.63661977236758134308);
    const float r = (float)(a - nq * 1.57079632679489661923);
    const int q = (int)nq & 3;
    const float r2 = r * r;
    const float sp = r + r * r2 * (-1.6666667163e-01f + r2 * (8.3333337680e-03f + r2 * (-1.9841270114e-04f + r2 * 2.7557314297e-06f)));
    const float cp = 1.f + r2 * (-0.5f + r2 * (4.1666667908e-02f + r2 * (-1.3888889225e-03f + r2 * (2.4801587642e-05f + r2 * -2.7557314297e-07f))));
    const float ss = (q & 1) ? cp : sp, cc = (q & 1) ? sp : cp;
    s = (q & 2) ? -ss : ss;
    c = ((q + 1) & 2) ? -cc : cc;
}

__device__ __forceinline__ void prologue(const Params& p, unsigned char* ws, LAS unsigned char* lds) {
    const int tid = tid_l(), lane = tid & 63, wave = tid >> 6;
    const int gw = blockIdx.x * 8 + wave, NGW = gridDim.x * 8;
    const int gt = blockIdx.x * 512 + tid, NGT = gridDim.x * 512;
    if (blockIdx.x == 0 && tid < 64) ((unsigned*)(ws + WS_CTL))[tid] = 0u;
    LAS float* scr = (LAS float*)(lds + wave * 8448);
    for (int it = gw; it < p.nitems; it += NGW) {
        int s = 0;
        while (s + 1 < p.nseg && it >= p.seg[s + 1].item0) ++s;
        transpose_item(p.seg[s], it - p.seg[s].item0, scr, lane);
    }
    const float* x = p.in[0]; bf16_t* xb = (bf16_t*)(ws + WS_XB);
    for (int i0 = gt; i0 < MTOK * DM / 8; i0 += 4 * NGT) {
        f32x4 a[4], b[4];
#pragma unroll
        for (int k = 0; k < 4; ++k) { const int i = i0 + k * NGT; if (i < MTOK * DM / 8) { a[k] = *(const f32x4*)(x + (size_t)i * 8); b[k] = *(const f32x4*)(x + (size_t)i * 8 + 4); } }
#pragma unroll
        for (int k = 0; k < 4; ++k) { const int i = i0 + k * NGT; if (i < MTOK * DM / 8) {
            u32x4 o; o.x = cvt_pk_bf16(a[k][0], a[k][1]); o.y = cvt_pk_bf16(a[k][2], a[k][3]); o.z = cvt_pk_bf16(b[k][0], b[k][1]); o.w = cvt_pk_bf16(b[k][2], b[k][3]);
            *(u32x4*)(xb + (size_t)i * 8) = o; } }
    }
    { float* wfT = (float*)(ws + WS_WF); const float* cdw = p.in[8];
      for (int i = gt; i < 8 * DM; i += NGT) { const int h = i >> 10, k = i & (DM - 1); wfT[i] = cdw[(size_t)k * 3080 + 1536 + h]; } }
    float* cosT = (float*)(ws + WS_ROPE); float* sinT = cosT + SEQ * 16;
    const float invf[16] = {1.000000000e+00f, 5.623413324e-01f, 3.162277639e-01f, 1.778279394e-01f, 1.000000015e-01f, 5.623413250e-02f, 3.162277490e-02f, 1.778279431e-02f,
                            9.999999776e-03f, 5.623413250e-03f, 3.162277630e-03f, 1.778279431e-03f, 1.000000047e-03f, 5.623413017e-04f, 3.162277571e-04f, 1.778279402e-04f};
    for (int i = gt; i < SEQ * 16; i += NGT) {
        const int pos = i >> 4, j = i & 15;
        float fr = invf[0];
#pragma unroll
        for (int k = 1; k < 16; ++k) fr = (j == k) ? invf[k] : fr;
        const float ang = (float)pos * fr;
        float c, s; sincos_reduced(ang, c, s);
        cosT[i] = c; sinT[i] = s;
    }
}

template <bool FL>
__device__ __forceinline__ void ln_phase(const float* y, float* outf, bf16_t* outb, float* stats, const float* g, const float* bt, const float* wf, const float* bforget, float* lsout) {
    const int tid = tid_l(), lane = tid & 63, wave = tid >> 6;
    const int gw = blockIdx.x * 8 + wave, NGW = gridDim.x * 8;
    f32x4 gv[4], bv[4];
#pragma unroll
    for (int j = 0; j < 4; ++j) { gv[j] = *(const f32x4*)(g + 256 * j + 4 * lane); bv[j] = *(const f32x4*)(bt + 256 * j + 4 * lane); }
    f32x4 wfr[FL ? 8 : 1][4];
    if (FL) {
#pragma unroll
        for (int h = 0; h < 8; ++h)
#pragma unroll
            for (int j = 0; j < 4; ++j) wfr[h][j] = *(const f32x4*)(wf + h * DM + 256 * j + 4 * lane);
    }
    f32x4 nx[4];
    if (gw < MTOK) {
#pragma unroll
        for (int j = 0; j < 4; ++j) nx[j] = *(const f32x4*)(y + (size_t)gw * DM + 4 * lane + 256 * j);
    }
    for (int row = gw; row < MTOK; row += NGW) {
        f32x4 v[4]; float s = 0.f;
#pragma unroll
        for (int j = 0; j < 4; ++j) { v[j] = nx[j]; s += (v[j][0] + v[j][1]) + (v[j][2] + v[j][3]); }
        if (row + NGW < MTOK) {
#pragma unroll
            for (int j = 0; j < 4; ++j) nx[j] = *(const f32x4*)(y + (size_t)(row + NGW) * DM + 4 * lane + 256 * j);
        }
        const float mean = wave_sum(s) * (1.f / DM); float s2 = 0.f;
#pragma unroll
        for (int j = 0; j < 4; ++j) { v[j] = v[j] - mean; s2 += (v[j][0] * v[j][0] + v[j][1] * v[j][1]) + (v[j][2] * v[j][2] + v[j][3] * v[j][3]); }
        const float rstd = 1.f / sqrtf(wave_sum(s2) * (1.f / DM) + LN_EPS);
        if (stats && lane == 0) { f32x2_t st = {mean, rstd}; *(f32x2_t*)(stats + 2 * (size_t)row) = st; }
        float facc[8];
#pragma unroll
        for (int h = 0; h < 8; ++h) facc[h] = 0.f;
#pragma unroll
        for (int j = 0; j < 4; ++j) {
            const f32x4 o = v[j] * rstd * gv[j] + bv[j];
            if (FL) {
#pragma unroll
                for (int h = 0; h < 8; ++h) facc[h] += (o[0] * wfr[h][j][0] + o[1] * wfr[h][j][1]) + (o[2] * wfr[h][j][2] + o[3] * wfr[h][j][3]);
            }
            if (outf) *(f32x4*)(outf + (size_t)row * DM + 256 * j + 4 * lane) = o;
            if (outb) { u32x2 w; w.x = cvt_pk_bf16(o[0], o[1]); w.y = cvt_pk_bf16(o[2], o[3]); *(u32x2*)(outb + (size_t)row * DM + 256 * j + 4 * lane) = w; }
        }
        if (FL) {
            float f4[4], f2[2], f1;
            { const bool up = (lane & 32) != 0;
#pragma unroll
              for (int i = 0; i < 4; ++i) { const float keep = up ? facc[4 + i] : facc[i], give = up ? facc[i] : facc[4 + i]; f4[i] = keep + __shfl_xor(give, 32); } }
            { const bool up = (lane & 16) != 0;
#pragma unroll
              for (int i = 0; i < 2; ++i) { const float keep = up ? f4[2 + i] : f4[i], give = up ? f4[i] : f4[2 + i]; f2[i] = keep + __shfl_xor(give, 16); } }
            { const bool up = (lane & 8) != 0; const float keep = up ? f2[1] : f2[0], give = up ? f2[0] : f2[1]; f1 = keep + __shfl_xor(give, 8); }
            f1 += __shfl_xor(f1, 4); f1 += __shfl_xor(f1, 2); f1 += __shfl_xor(f1, 1);
            if ((lane & 7) == 0) { const int h = ((lane >> 5) & 1) * 4 + ((lane >> 4) & 1) * 2 + ((lane >> 3) & 1);
                const float z = f1 + bforget[h]; lsout[(size_t)row * 8 + h] = fminf(z, 0.f) - log1pf(expf(-fabsf(z))); }
        }
    }
}

__device__ __forceinline__ void rownorm_phase(unsigned char* ws) {
    const int tid = tid_l(), lane = tid & 63, wave = tid >> 6;
    const int gw = blockIdx.x * 8 + wave, NGW = gridDim.x * 8;
    const bf16_t* proj = (const bf16_t*)(ws + WS_BIG);
    float* rsq = (float*)(ws + WS_RSQ); float* rskv = (float*)(ws + WS_RSKV);
    bf16_t* kro = (bf16_t*)(ws + WS_KROPE);
    const float* cosT = (const float*)(ws + WS_ROPE); const float* sinT = cosT + SEQ * 16;
    const int sub = lane >> 4, l16 = lane & 15;
    for (int r4 = gw * 4; r4 < MTOK; r4 += NGW * 4) {
        const int row = r4 + sub;
        const bf16_t* pr = proj + (size_t)row * N0;
        float sq = 0.f, skv = 0.f;
        u32x4 vq[3], vk[2];
#pragma unroll
        for (int i = 0; i < 3; ++i) vq[i] = *(const u32x4*)(pr + (l16 + 16 * i) * 8);
#pragma unroll
        for (int i = 0; i < 2; ++i) vk[i] = *(const u32x4*)(pr + 384 + (l16 + 16 * i) * 8);
        const float x1 = __uint_as_float((unsigned)pr[640 + l16] << 16), x2 = __uint_as_float((unsigned)pr[656 + l16] << 16);
#pragma unroll
        for (int i = 0; i < 3; ++i)
#pragma unroll
            for (int e = 0; e < 4; ++e) { const float a = bf_lo(vq[i][e]), b = bf_hi(vq[i][e]); sq += a * a + b * b; }
#pragma unroll
        for (int i = 0; i < 2; ++i)
#pragma unroll
            for (int e = 0; e < 4; ++e) { const float a = bf_lo(vk[i][e]), b = bf_hi(vk[i][e]); skv += a * a + b * b; }
#pragma unroll
        for (int o = 1; o < 16; o <<= 1) { sq += __shfl_xor(sq, o); skv += __shfl_xor(skv, o); }
        if (l16 == 0) { rsq[row] = 1.f / sqrtf(sq * (1.f / 384.f) + RMS_EPS); rskv[row] = 1.f / sqrtf(skv * (1.f / 256.f) + RMS_EPS); }
        {
            const int pos = row & (SEQ - 1);
            const float c = cosT[pos * 16 + l16], sn = sinT[pos * 16 + l16];
            const unsigned o = cvt_pk_bf16(x1 * c - x2 * sn, x1 * sn + x2 * c);
            kro[(size_t)row * 32 + l16] = (bf16_t)(o & 0xffffu); kro[(size_t)row * 32 + 16 + l16] = (bf16_t)(o >> 16);
        }
    }
}

__device__ __forceinline__ void scan_phase(const Params& p, unsigned char* ws, LAS unsigned char* lds) {
    const int tid = tid_l(), lane = tid & 63, wave = tid >> 6;
    const float* flog = (const float*)(ws + WS_FLOG); float* cum = (float*)(ws + WS_CUM);
    LAS float* wtot = (LAS float*)lds;
    for (int bh = blockIdx.x; bh < 64; bh += gridDim.x) {
        const int b = bh >> 3, h = bh & 7;
        float v[8]; float run = 0.f;
#pragma unroll
        for (int i = 0; i < 8; ++i) {
            run += flog[((size_t)b * SEQ + tid * 8 + i) * 8 + h]; v[i] = run;
        }
        float inc = run;
#pragma unroll
        for (int o = 1; o < 64; o <<= 1) { const float t = __shfl_up(inc, o); if (lane >= o) inc += t; }
        __syncthreads();
        if (lane == 63) wtot[wave] = inc;
        __syncthreads();
        float off = inc - run;
        for (int w2 = 0; w2 < wave; ++w2) off += wtot[w2];
#pragma unroll
        for (int i = 0; i < 8; ++i) cum[(size_t)bh * SEQ + tid * 8 + i] = (off + v[i]) * LOG2E;
    }
    __syncthreads();
}

constexpr int AT_KBUF = 12288, AT_NBUF = 4, AT_VOFF = AT_NBUF * AT_KBUF, AT_VBUF = 8192, AT_REL = AT_VOFF + AT_NBUF * AT_VBUF, AT_CK = AT_REL + 1280, AT_UNIT = AT_CK + AT_NBUF * 1024;
constexpr float NEG_BIG = -1e30f;
#define MX3(a, b, c) __builtin_fmaxf(__builtin_fmaxf((a), (b)), (c))
typedef __bf16 bf16x2_t __attribute__((ext_vector_type(2)));
__device__ __forceinline__ unsigned cvtpk(float lo, float hi) { f32x2_t v = {lo, hi}; bf16x2_t b = __builtin_convertvector(v, bf16x2_t); return __builtin_bit_cast(unsigned, b); }
__device__ __forceinline__ void glds16(const void* gsrc, unsigned lds_dst) { unsigned keep;
    asm volatile("s_mov_b32 %0, m0\n\ts_mov_b32 m0, %2\n\ts_nop 0\n\tglobal_load_lds_dwordx4 %1, off\n\ts_mov_b32 m0, %0" : "=&s"(keep) : "v"(gsrc), "s"(lds_dst) : "memory"); }

template <int TYPE>
__device__ __forceinline__ void attn_unit(const Params& p, unsigned char* ws, int bh, int qb, LAS unsigned char* lds) {
    constexpr int DQK = (TYPE == 0) ? 96 : 64, ND = DQK / 16;
    const int tid = tid_l(), lane = tid & 63, w = __builtin_amdgcn_readfirstlane(tid >> 6), ql = lane & 31, hi = lane >> 5;
    const int b = bh >> 3, h = (bh & 7) + ((TYPE == 1) ? (w >> 2) : 0);
    const size_t rb = (size_t)b * SEQ;
    const int q0 = (TYPE == 1) ? qb * 128 : qb * 256, qpos = q0 + 32 * ((TYPE == 1) ? (w & 3) : w) + ql;
    const bf16_t* PROJ = (const bf16_t*)(ws + WS_BIG);
    const bf16_t *Qp, *K0p, *Vp; int ldq, ldk, ocol;
    if (TYPE == 0) { Qp = (const bf16_t*)(ws + WS_Q) + h * 96; ldq = 768; K0p = (const bf16_t*)(ws + WS_KV) + h * 128; Vp = K0p + 64; ldk = 1024; ocol = h * 64; }
    else if (TYPE == 1) { Qp = PROJ + 672 + h * 64; ldq = N0; K0p = PROJ + 1184 + (h >> 2) * 64; Vp = PROJ + 1312 + (h >> 2) * 64; ldk = N0; ocol = 512 + h * 64; }
    else if (TYPE == 2) { Qp = PROJ + h * 64; ldq = 512; K0p = PROJ + (size_t)1 * MTOK * 512 + h * 64; Vp = PROJ + (size_t)2 * MTOK * 512 + h * 64; ldk = 512; ocol = h * 64; }
    else { Qp = PROJ + (size_t)3 * MTOK * 512 + h * 64; ldq = 512; K0p = PROJ + (size_t)4 * MTOK * 512 + h * 64; Vp = PROJ + (size_t)5 * MTOK * 512 + h * 64; ldk = 512; ocol = 512 + h * 64; }

    const float* cumk = (const float*)(ws + WS_CUM) + (size_t)bh * SEQ;
    const int cw = (TYPE == 1) ? 2 * qb + ((w & 3) >> 1) : 4 * qb + (w >> 1), t_hi = (TYPE == 1) ? 2 * qb + 1 : 4 * qb + 3;
    int t_lo = 0, w_lo = 0;
    if (TYPE == 1) { t_lo = max(0, 2 * qb - 2); w_lo = max(0, cw - 2); }
    if (TYPE == 3) { t_lo = max(0, 4 * qb - 8); w_lo = max(0, cw - 8); }

    const unsigned ldsb = (unsigned)(size_t)lds;
    const bf16_t* kgl = K0p + (rb + lane) * ldk + w * 8;
    const bf16_t* rgl = (const bf16_t*)(ws + WS_KROPE) + (rb + lane) * 32 + (w & 3) * 8;
    const bf16_t* vgl = Vp + (rb + 16 * (w & 3) + (lane >> 2)) * ldk + (w >> 2) * 32 + (lane & 3) * 8;
#define AT_LOADK(t, buf) do { glds16(kgl + (size_t)(t) * 64 * ldk, ldsb + (buf) * AT_KBUF + w * 1024); \
        if (TYPE == 0 && w < 4) glds16(rgl + (size_t)(t) * 64 * 32, ldsb + (buf) * AT_KBUF + (8 + w) * 1024); } while (0)
#define AT_LOADV(t, buf) do { glds16(vgl + (size_t)(t) * 64 * ldk, ldsb + AT_VOFF + (buf) * AT_VBUF + (w >> 2) * 4096 + (w & 3) * 1024); \
        if (TYPE == 2 && w == 7) glds16(cumk + (t) * 64 + lane * 4, ldsb + AT_CK + (buf) * 1024); } while (0)
#define AT_WAITBAR_FULL() do { if ((TYPE == 0 && w < 4) || (TYPE == 2 && w == 7)) asm volatile("s_waitcnt vmcnt(3) lgkmcnt(0)\n\ts_barrier" ::: "memory"); \
        else asm volatile("s_waitcnt vmcnt(2) lgkmcnt(0)\n\ts_barrier" ::: "memory"); } while (0)
#define AT_WAITBAR_ALL() asm volatile("s_waitcnt vmcnt(0) lgkmcnt(0)\n\ts_barrier" ::: "memory")

    AT_LOADK(t_lo, 0); AT_LOADV(t_lo, 0); AT_LOADK(t_lo + 1, 1); AT_LOADV(t_lo + 1, 1);
    bf16x8 qf[ND];
    {
        const bf16_t* qp = Qp + (rb + qpos) * ldq + 8 * hi;
#pragma unroll
        for (int d0 = 0; d0 < ND; ++d0) qf[d0] = *(const bf16x8*)(qp + 16 * d0);
        if (TYPE == 0) {
            const float* cosT = (const float*)(ws + WS_ROPE); const float* sinT = cosT + SEQ * 16;
            const u32x4 a = __builtin_bit_cast(u32x4, qf[4]), bq = __builtin_bit_cast(u32x4, qf[5]);
            const f32x4 c0 = *(const f32x4*)(cosT + qpos * 16 + 8 * hi), c1 = *(const f32x4*)(cosT + qpos * 16 + 8 * hi + 4);
            const f32x4 s0 = *(const f32x4*)(sinT + qpos * 16 + 8 * hi), s1 = *(const f32x4*)(sinT + qpos * 16 + 8 * hi + 4);
            u32x4 o1, o2;
#pragma unroll
            for (int e = 0; e < 4; ++e) {
                const float x1l = bf_lo(a[e]), x1h = bf_hi(a[e]), x2l = bf_lo(bq[e]), x2h = bf_hi(bq[e]);
                const float cl = (e < 2) ? c0[2 * e] : c1[2 * e - 4], ch = (e < 2) ? c0[2 * e + 1] : c1[2 * e - 3];
                const float sl = (e < 2) ? s0[2 * e] : s1[2 * e - 4], sh = (e < 2) ? s0[2 * e + 1] : s1[2 * e - 3];
                o1[e] = cvtpk(x1l * cl - x2l * sl, x1h * ch - x2h * sh);
                o2[e] = cvtpk(x1l * sl + x2l * cl, x1h * sh + x2h * ch);
            }
            qf[4] = __builtin_bit_cast(bf16x8, o1); qf[5] = __builtin_bit_cast(bf16x8, o2);
        }
    }
#pragma unroll
    for (int d0 = 0; d0 < ND; ++d0) asm volatile("" : "+v"(qf[d0]));
    float cq2 = 0.f, slope2 = 0.f, rfar = 0.f;
    if (TYPE == 2) cq2 = cumk[qpos];
    if (TYPE == 1) slope2 = __builtin_amdgcn_exp2f(-(float)(h + 1)) * LOG2E;
    LAS float* relb = (LAS float*)(lds + AT_REL);
    if (TYPE == 3) { if (tid < 320) relb[tid] = p.in[10][tid * 8 + h] * LOG2E; rfar = p.in[10][319 * 8 + h] * LOG2E; }
    asm volatile("" : "+v"(cq2), "+v"(rfar));
    const float qposf = (float)qpos;

    f32x16 oT0, oT1, negm, s0, s1;
#pragma unroll
    for (int r = 0; r < 16; ++r) { oT0[r] = 0.f; oT1[r] = 0.f; negm[r] = cq2; s0[r] = 0.f; s1[r] = 0.f; }
    float mrow = 0.f, lrow = 0.f;
    const unsigned kfrag = hi * 1024 + ql * 16;
    const unsigned vfrag = AT_VOFF + (4 * hi + ((lane & 15) >> 2)) * 64 + ((lane >> 4) & 1) * 32 + (lane & 3) * 8;
#define SBAR() __builtin_amdgcn_sched_barrier(0)

    AT_WAITBAR_ALL();
    const int npair = (t_hi - t_lo + 1) >> 1;
    for (int pp = 0; pp < npair; ++pp) {
        const int sb = (pp & 1) * 2;
        if (pp + 1 < npair) { const int tn = t_lo + 2 * pp + 2; AT_LOADK(tn, sb ^ 2); AT_LOADV(tn, sb ^ 2); AT_LOADK(tn + 1, (sb ^ 2) + 1); AT_LOADV(tn + 1, (sb ^ 2) + 1); }
        bf16x8 kf0[ND], kf1[ND]; bool have = false;
#pragma unroll
        for (int d0 = 0; d0 < ND; ++d0) { kf0[d0] = (bf16x8){0, 0, 0, 0, 0, 0, 0, 0}; kf1[d0] = kf0[d0]; }
#pragma unroll
        for (int u2 = 0; u2 < 2; ++u2) {
        const int t = t_lo + 2 * pp + u2, bc = sb + u2;
        if (t >= w_lo && t <= cw) {
            if (!have) {
                const LAS unsigned char* kb = lds + bc * AT_KBUF + kfrag;
#pragma unroll
                for (int d0 = 0; d0 < ND; ++d0) { kf0[d0] = *(const LAS bf16x8*)(kb + d0 * 2048); kf1[d0] = *(const LAS bf16x8*)(kb + d0 * 2048 + 512); }
            }
            have = false;
            SBAR();
#pragma unroll
            for (int d0 = 0; d0 < ND; ++d0) {
                if (d0 == 0) { s0 = __builtin_amdgcn_mfma_f32_32x32x16_bf16(kf0[0], qf[0], negm, 0, 0, 0); s1 = __builtin_amdgcn_mfma_f32_32x32x16_bf16(kf1[0], qf[0], negm, 0, 0, 0); }
                else { s0 = __builtin_amdgcn_mfma_f32_32x32x16_bf16(kf0[d0], qf[d0], s0, 0, 0, 0); s1 = __builtin_amdgcn_mfma_f32_32x32x16_bf16(kf1[d0], qf[d0], s1, 0, 0, 0); }
            }
            SBAR();
            long vl0[4], vh0[4], vl1[4], vh1[4];
            const LAS unsigned char* vb = lds + bc * AT_VBUF + vfrag;
#pragma unroll
            for (int ks = 0; ks < 4; ++ks) {
                vl0[ks] = __builtin_bit_cast(long, __builtin_amdgcn_ds_read_tr16_b64_v4i16((LAS s16x4*)(vb + ks * 1024)));
                vh0[ks] = __builtin_bit_cast(long, __builtin_amdgcn_ds_read_tr16_b64_v4i16((LAS s16x4*)(vb + ks * 1024 + 512)));
                vl1[ks] = __builtin_bit_cast(long, __builtin_amdgcn_ds_read_tr16_b64_v4i16((LAS s16x4*)(vb + 4096 + ks * 1024)));
                vh1[ks] = __builtin_bit_cast(long, __builtin_amdgcn_ds_read_tr16_b64_v4i16((LAS s16x4*)(vb + 4096 + ks * 1024 + 512)));
            }
            SBAR();
            const int kbase = 64 * t + 4 * hi;
            if (TYPE == 1) {
                const float d0f = qposf - (float)kbase;
#pragma unroll
                for (int r = 0; r < 16; ++r) { const float off = (float)((r & 3) + 8 * (r >> 2));
                    s0[r] = s0[r] - slope2 * fabsf(d0f - off); s1[r] = s1[r] - slope2 * fabsf(d0f - off - 32.f); }
            } else if (TYPE == 2) {
                const LAS float* ck = (const LAS float*)(lds + AT_CK + bc * 1024) + 4 * hi;
#pragma unroll
                for (int g4 = 0; g4 < 4; ++g4) {
                    const f32x4 c0 = *(const LAS f32x4*)(ck + 8 * g4), c1 = *(const LAS f32x4*)(ck + 8 * g4 + 32);
#pragma unroll
                    for (int e = 0; e < 4; ++e) { s0[4 * g4 + e] -= c0[e]; s1[4 * g4 + e] -= c1[e]; }
                }
                if (t == cw) {
#pragma unroll
                    for (int r = 0; r < 16; ++r) { const int s = kbase + (r & 3) + 8 * (r >> 2);
                        s0[r] = (s <= qpos) ? s0[r] : NEG_BIG; s1[r] = (s + 32 <= qpos) ? s1[r] : NEG_BIG; }
                }
            } else if (TYPE == 3) {
                if (cw - t >= 5) {
#pragma unroll
                    for (int r = 0; r < 16; ++r) { s0[r] += rfar; s1[r] += rfar; }
                } else if (cw - t <= 3) {
                    const LAS float* rb2 = relb + (qpos - kbase - 28);
#pragma unroll
                    for (int r = 0; r < 16; ++r) { const int o = (r & 3) + 8 * (r >> 2); s0[r] += rb2[91 - o]; s1[r] += rb2[59 - o]; }
                } else {
                    const int dq = qpos - kbase;
#pragma unroll
                    for (int r = 0; r < 16; ++r) { const int d = dq - ((r & 3) + 8 * (r >> 2));
                        s0[r] += relb[min(d, 256) + 63]; s1[r] += relb[min(d - 32, 256) + 63]; }
                }
            }
            float ma = MX3(s0[0], s0[1], s1[0]), mb = MX3(s0[2], s0[3], s1[1]); ma = MX3(ma, s1[2], s1[3]);
#pragma unroll
            for (int r = 4; r < 16; r += 4) { ma = MX3(ma, s0[r], s0[r + 1]); mb = MX3(mb, s0[r + 2], s0[r + 3]); ma = MX3(ma, s1[r], s1[r + 1]); mb = MX3(mb, s1[r + 2], s1[r + 3]); }
            const float mx = half_max(fmaxf(ma, mb));
            if (__any(mx > 8.f)) {
                const float dl = fmaxf(mx, 0.f);
                mrow += dl;
                const float f = __builtin_amdgcn_exp2f(-dl);
                lrow *= f;
#pragma unroll
                for (int r = 0; r < 16; ++r) { s0[r] -= dl; s1[r] -= dl; negm[r] -= dl; oT0[r] *= f; oT1[r] *= f; }
            }
            float la = 0.f, lb = 0.f, lc = 0.f, ld = 0.f;
            bf16x8 pf[4];
#pragma unroll
            for (int r = 0; r < 16; r += 2) { s0[r] = __builtin_amdgcn_exp2f(s0[r]); s0[r + 1] = __builtin_amdgcn_exp2f(s0[r + 1]); la += s0[r]; lb += s0[r + 1]; }
            { u32x4 w0, w1;
              w0.x = cvtpk(s0[0], s0[1]); w0.y = cvtpk(s0[2], s0[3]); w0.z = cvtpk(s0[4], s0[5]); w0.w = cvtpk(s0[6], s0[7]);
              w1.x = cvtpk(s0[8], s0[9]); w1.y = cvtpk(s0[10], s0[11]); w1.z = cvtpk(s0[12], s0[13]); w1.w = cvtpk(s0[14], s0[15]);
              pf[0] = __builtin_bit_cast(bf16x8, w0); pf[1] = __builtin_bit_cast(bf16x8, w1); }
            SBAR();
#define AT_PV(ks) do { const bf16x8 v0_ = __builtin_bit_cast(bf16x8, (i64x2){vl0[ks], vh0[ks]}); const bf16x8 v1_ = __builtin_bit_cast(bf16x8, (i64x2){vl1[ks], vh1[ks]}); \
                oT0 = __builtin_amdgcn_mfma_f32_32x32x16_bf16(v0_, pf[ks], oT0, 0, 0, 0); oT1 = __builtin_amdgcn_mfma_f32_32x32x16_bf16(v1_, pf[ks], oT1, 0, 0, 0); } while (0)
            AT_PV(0);
            SBAR();
#pragma unroll
            for (int r = 0; r < 8; r += 2) { s1[r] = __builtin_amdgcn_exp2f(s1[r]); s1[r + 1] = __builtin_amdgcn_exp2f(s1[r + 1]); lc += s1[r]; ld += s1[r + 1]; }
            SBAR();
            AT_PV(1);
            SBAR();
#pragma unroll
            for (int r = 8; r < 16; r += 2) { s1[r] = __builtin_amdgcn_exp2f(s1[r]); s1[r + 1] = __builtin_amdgcn_exp2f(s1[r + 1]); lc += s1[r]; ld += s1[r + 1]; }
            lrow += (la + lb) + (lc + ld);
            { u32x4 w2, w3;
              w2.x = cvtpk(s1[0], s1[1]); w2.y = cvtpk(s1[2], s1[3]); w2.z = cvtpk(s1[4], s1[5]); w2.w = cvtpk(s1[6], s1[7]);
              w3.x = cvtpk(s1[8], s1[9]); w3.y = cvtpk(s1[10], s1[11]); w3.z = cvtpk(s1[12], s1[13]); w3.w = cvtpk(s1[14], s1[15]);
              pf[2] = __builtin_bit_cast(bf16x8, w2); pf[3] = __builtin_bit_cast(bf16x8, w3); }
            SBAR();
            if (u2 == 0 && t + 1 >= w_lo && t + 1 <= cw) {
                const LAS unsigned char* kb2 = lds + (bc + 1) * AT_KBUF + kfrag;
#pragma unroll
                for (int d0 = 0; d0 < ND; ++d0) { kf0[d0] = *(const LAS bf16x8*)(kb2 + d0 * 2048); kf1[d0] = *(const LAS bf16x8*)(kb2 + d0 * 2048 + 512); }
                have = true;
            }
            AT_PV(2); AT_PV(3);
#undef AT_PV
            SBAR();
        }
        }
        AT_WAITBAR_ALL();
    }
#undef SBAR
#undef AT_LOADK
#undef AT_LOADV
#undef AT_WAITBAR_FULL
#undef AT_WAITBAR_ALL
    float ltot = half_sum(lrow);
    if (TYPE == 1) ltot += __builtin_amdgcn_exp2f(p.in[6][h] * LOG2E - mrow);
    const float inv = 1.f / ltot;
    bf16_t* op = (bf16_t*)(ws + WS_O) + (rb + qpos) * DM + ocol + 4 * hi;
#pragma unroll
    for (int g4 = 0; g4 < 4; ++g4) {
        u32x2 w0, w1;
        w0.x = cvtpk(oT0[4 * g4] * inv, oT0[4 * g4 + 1] * inv); w0.y = cvtpk(oT0[4 * g4 + 2] * inv, oT0[4 * g4 + 3] * inv);
        w1.x = cvtpk(oT1[4 * g4] * inv, oT1[4 * g4 + 1] * inv); w1.y = cvtpk(oT1[4 * g4 + 2] * inv, oT1[4 * g4 + 3] * inv);
        *(u32x2*)(op + 8 * g4) = w0; *(u32x2*)(op + 32 + 8 * g4) = w1;
    }
}

template <int TCAUSAL, int TBAND>
__device__ __forceinline__ void attn_phase(const Params& p, unsigned char* ws, LAS unsigned char* lds, unsigned* ctr) {
    LAS int* su = (LAS int*)(lds + AT_UNIT);
    const int tid0 = tid_l();
    __syncthreads();
    if (tid0 == 0) su[0] = (int)atomicAdd(ctr, 1u);
    __syncthreads();
    int cur = 0;
    for (;;) {
        const int u = su[cur];
        if (u >= 2048) break;
        int nxt = 0;
        if (tid0 == 0) nxt = (int)atomicAdd(ctr, 1u);
        if (u < 1024) attn_unit<TCAUSAL>(p, ws, u & 63, 15 - (u >> 6), lds);
        else if (TBAND == 1) { const int j = u - 1024; attn_unit<TBAND>(p, ws, ((j & 31) >> 2) * 8 + (j & 3) * 2, 31 - (j >> 5), lds); }
        else attn_unit<TBAND>(p, ws, (u - 1024) & 63, 15 - ((u - 1024) >> 6), lds);
        if (tid0 == 0) su[cur ^ 1] = nxt;
        __syncthreads();
        cur ^= 1;
    }
}

#define XB_TMO      128
#define XB_XCNT(j)  (256  + 64 * (j))
#define XB_XSUB(j)  (1280 + 64 * (j))
#define XB_XGEN(j)  (2304 + 64 * (j))
#define XB_TOP      3328
#define XB_TOPGEN   3392
#define XCD_BAR_WORDS 3456
#define XB_SPIN_CAP (1u << 18)
__device__ __forceinline__ unsigned xb_ld(unsigned* p)              { return __hip_atomic_load(p, __ATOMIC_RELAXED, __HIP_MEMORY_SCOPE_AGENT); }
__device__ __forceinline__ unsigned xb_add(unsigned* p, unsigned v) { return __hip_atomic_fetch_add(p, v, __ATOMIC_RELAXED, __HIP_MEMORY_SCOPE_AGENT); }
__device__ __forceinline__ unsigned xb_xcc_id() { return (unsigned)__builtin_amdgcn_s_getreg((3 << 11) | 20) & 0xFu; }
#define XB_SPIN(cond, bar) do { unsigned _sp = 0; while (cond) { __builtin_amdgcn_s_sleep(1); \
    if ((++_sp & 255u) == 0u) { if (xb_ld(&(bar)[XB_TMO])) break; if (_sp > XB_SPIN_CAP) { atomicAdd(&(bar)[XB_TMO], 1u); break; } } } } while (0)
struct XcdBarrier { unsigned* bar; unsigned x; volatile LAS unsigned* st; };
__device__ __forceinline__ XcdBarrier xcd_barrier_post(unsigned* bar, volatile LAS unsigned* st) {
    XcdBarrier b; b.bar = bar; b.x = xb_xcc_id(); b.st = st;
    if (threadIdx.x == 0) (void)xb_add(&bar[XB_XCNT(b.x)], 1u);
    return b;
}
__device__ __forceinline__ void xcd_barrier_complete(unsigned* bar, unsigned x, unsigned& nloc, unsigned& nx) {
    const unsigned G = gridDim.x * gridDim.y * gridDim.z;
    unsigned sum, cnt, mine, sp = 0u;
    for (;;) {
        sum = 0u; cnt = 0u; mine = 0u;
#pragma unroll
        for (unsigned j = 0; j < 16; ++j) { const unsigned c = xb_ld(&bar[XB_XCNT(j)]); sum += c; cnt += (c > 0u) ? 1u : 0u; mine = (j == x) ? c : mine; }
        if (sum == G) break;
        __builtin_amdgcn_s_sleep(1);
        if ((++sp & 255u) == 0u) { if (xb_ld(&bar[XB_TMO])) break; if (sp > XB_SPIN_CAP) { atomicAdd(&bar[XB_TMO], 1u); break; } }
    }
    nloc = mine > 0u ? mine : 1u; nx = cnt > 0u ? cnt : 1u;
}
__device__ __forceinline__ void xcd_barrier(const XcdBarrier& b) {
    asm volatile("s_waitcnt vmcnt(0)" ::: "memory");
    __syncthreads();
    if (threadIdx.x == 0) {
        unsigned* bar = b.bar;
        __builtin_amdgcn_s_waitcnt(0);
        unsigned nloc = b.st[0], nx = b.st[1];
        if (nloc == 0u) { xcd_barrier_complete(bar, b.x, nloc, nx); b.st[0] = nloc; b.st[1] = nx; }
        const unsigned old = xb_add(&bar[XB_XSUB(b.x)], 1u);
        const unsigned gen = old / nloc;
        if (old + 1u == (gen + 1u) * nloc) {
            __builtin_amdgcn_fence(__ATOMIC_RELEASE, "agent");
            asm volatile("s_waitcnt vmcnt(0)" ::: "memory");
            const unsigned og = xb_add(&bar[XB_TOP], 1u);
            const unsigned tg = og / nx;
            if (og + 1u == (tg + 1u) * nx) xb_add(&bar[XB_TOPGEN], 1u);
            else XB_SPIN(xb_ld(&bar[XB_TOPGEN]) == tg, bar);
            __builtin_amdgcn_fence(__ATOMIC_ACQUIRE, "agent");
            xb_add(&bar[XB_XGEN(b.x)], 1u);
            asm volatile("s_waitcnt vmcnt(0)" ::: "memory");
        } else {
            XB_SPIN(xb_ld(&bar[XB_XGEN(b.x)]) == gen, bar);
            __builtin_amdgcn_fence(__ATOMIC_ACQUIRE, "agent");
            asm volatile("s_waitcnt vmcnt(0)" ::: "memory");
        }
    }
    __syncthreads();
}

__global__ void __launch_bounds__(512, 2) mega(Params p) {
    extern __shared__ __attribute__((aligned(16))) unsigned char lds_raw[];
    LAS unsigned char* lds = (LAS unsigned char*)lds_raw;
    cg::grid_group grid = cg::this_grid();
    volatile LAS unsigned* bst = (volatile LAS unsigned*)(lds + LDS_BARW);
    if (threadIdx.x < 2) bst[threadIdx.x] = 0u;
    __syncthreads();
    XcdBarrier xbar = xcd_barrier_post((unsigned*)(p.ws + WS_BAR), bst);

    for (int ph = p.lo; ph < p.hi; ++ph) {
        if (ph == 11) continue;
        __attribute__((address_space(1))) unsigned char* gws = (__attribute__((address_space(1))) unsigned char*)p.ws;
        __attribute__((address_space(1))) float* gY = (__attribute__((address_space(1))) float*)p.out;
        asm volatile("" : "+s"(gws), "+s"(gY));
        unsigned char* ws = (unsigned char*)gws; float* Y = (float*)gY;
        bf16_t* XB = (bf16_t*)(ws + WS_XB);
        bf16_t* BIG = (bf16_t*)(ws + WS_BIG);
        bf16_t* OB = (bf16_t*)(ws + WS_O);
        unsigned* ctl = (unsigned*)(ws + WS_CTL);
        int ng = 0; pg8::Gemm g0, g1; pg8::Epi<0> e0, e1;
        e0.mode = 0; e0.O = nullptr; e0.ldc = 0; e0.rowscale = nullptr; e0.F32 = nullptr; e0.f32tile = -1; e0.res = nullptr; e0.out = nullptr; e0.lnstats = nullptr; e0.lng = nullptr; e0.lnb = nullptr; e1 = e0;
        g0.A = nullptr; g0.Bt = nullptr; g0.M = MTOK; g0.N = 0; g0.K = 0; g0.lda = 0; g0.ldb = 0; g1 = g0;
        const int L = (ph >= 10) ? 1 : 0;
        switch (ph) {
            case 1:  ng = 1; g0.A = XB; g0.lda = DM; g0.Bt = (const bf16_t*)(ws + WS_WIN0); g0.ldb = DM; g0.N = N0; g0.K = DM; e0.O = BIG; e0.ldc = N0; break;
            case 3:  ng = 2; g0.A = BIG; g0.lda = N0; g0.Bt = (const bf16_t*)(ws + WS_WUQ); g0.ldb = 384; g0.N = 768; g0.K = 384; e0.O = (bf16_t*)(ws + WS_Q); e0.ldc = 768; e0.rowscale = (const float*)(ws + WS_RSQ);
                     g1.A = BIG + 384; g1.lda = N0; g1.Bt = (const bf16_t*)(ws + WS_WUKV); g1.ldb = 256; g1.N = 1024; g1.K = 256; e1.O = (bf16_t*)(ws + WS_KV); e1.ldc = 1024; e1.rowscale = (const float*)(ws + WS_RSKV); break;
            case 5:  case 13: ng = 1; g0.A = OB; g0.lda = DM; g0.Bt = (const bf16_t*)(ws + (L ? WS_WOUT1 : WS_WOUT0)); g0.ldb = DM; g0.N = DM; g0.K = DM; e0.mode = 2; e0.res = (ph == 5) ? p.in[0] : Y; e0.out = Y;
                     if (ph == 13) { e0.lnstats = (const float*)(ws + WS_STATS); e0.lng = p.in[17]; e0.lnb = p.in[18]; } break;
            case 7:  case 15: ng = 1; g0.A = XB; g0.lda = DM; g0.Bt = (const bf16_t*)(ws + (L ? WS_WGU1 : WS_WGU0)); g0.ldb = DM; g0.N = 2 * DFF; g0.K = DM; e0.mode = 1; e0.O = BIG; break;
            case 8:  case 16: ng = 1; g0.A = BIG; g0.lda = DFF; g0.Bt = (const bf16_t*)(ws + (L ? WS_WDN1 : WS_WDN0)); g0.ldb = DFF; g0.N = DM; g0.K = DFF; e0.mode = 2; e0.res = Y; e0.out = Y; e0.lnstats = (const float*)(ws + WS_STATS); e0.lng = p.in[12] + L * DM; e0.lnb = p.in[13] + L * DM; break;
            case 10: ng = 1; g0.A = XB; g0.lda = DM; g0.Bt = (const bf16_t*)(ws + WS_WIN1); g0.ldb = DM; g0.N = N1; g0.K = DM; e0.O = BIG; e0.ldc = 512; e0.f32tile = 512; break;
            default: break;
        }
        const int nrep = (ph == PROBE_REP) ? 2 : 1;
        for (int rep = 0; rep < nrep; ++rep) {
        if (ph == 10) scan_phase(p, ws, lds);
        for (int j = 0; j < ng; ++j) {
            const pg8::Gemm gg = j ? g1 : g0; const pg8::Epi<0> ee = j ? e1 : e0;
            pg8::StaticOrder S; S.init(gg.M, gg.N, (int)gridDim.x, (int)blockIdx.x);
#define EPI_COPY(T, x) pg8::Epi<T> x; x.mode = ee.mode; x.O = ee.O; x.ldc = ee.ldc; x.rowscale = ee.rowscale; x.F32 = ee.F32; x.f32tile = ee.f32tile; x.res = ee.res; x.out = ee.out; x.lnstats = ee.lnstats; x.lng = ee.lng; x.lnb = ee.lnb
            if (ee.mode == 0 && ee.rowscale == nullptr) pg8::gemm_phase(lds, gg, S, ee);
            else if (ee.mode == 0) { EPI_COPY(4, e4t); pg8::gemm_phase(lds, gg, S, e4t); }
            else if (ee.mode == 1) { EPI_COPY(1, e1t); pg8::gemm_phase(lds, gg, S, e1t); }
            else if (ee.lnstats == nullptr) { EPI_COPY(2, e2t); pg8::gemm_phase(lds, gg, S, e2t); }
            else { EPI_COPY(3, e3t); pg8::gemm_phase(lds, gg, S, e3t); }
#undef EPI_COPY
        }
        if (ph == 0) prologue(p, ws, lds);
        else if (ph == 2) rownorm_phase(ws);
        else if (ph == 4) attn_phase<0, 1>(p, ws, lds, ctl + 0 + 2 * rep);
        else if (ph == 12) attn_phase<2, 3>(p, ws, lds, ctl + 1 + 2 * rep);
        else if (ph == 6 || ph == 9 || ph == 14 || ph == 17) {
            const int which = (ph == 6 || ph == 14) ? 0 : 1;
            const float* gsrc = p.in[which ? 17 : 12] + L * DM; const float* bsrc = p.in[which ? 18 : 13] + L * DM;
            if (ph == 17) ln_phase<false>(Y, Y, nullptr, nullptr, gsrc, bsrc, nullptr, nullptr, nullptr);
            else if (ph == 9) ln_phase<true>(Y, nullptr, XB, (float*)(ws + WS_STATS), gsrc, bsrc, (const float*)(ws + WS_WF), p.in[9], (float*)(ws + WS_FLOG));
            else ln_phase<false>(Y, nullptr, XB, (float*)(ws + WS_STATS), gsrc, bsrc, nullptr, nullptr, nullptr);
        }
        if (rep + 1 < nrep) xcd_barrier(xbar);
        }
        if (ph + 1 < p.hi) { if (p.hi > NPH) grid.sync(); else xcd_barrier(xbar); }
    }
}

extern "C" void kernel_launch(void* const* d_in, const int* in_sizes, int n_in, void* d_out, int out_size, void* d_ws, size_t ws_size, hipStream_t stream) {
    static int grid = 0;
    if (grid == 0) {
        if (n_in != 19 || out_size != MTOK * DM || ws_size < WS_END) { fprintf(stderr, "kernel_launch: unexpected shapes (n_in %d out %d ws %zu)\n", n_in, out_size, ws_size); grid = -1; return; }
        int dev = 0, cus = 0, per_cu = 0;
        hipGetDevice(&dev); hipDeviceGetAttribute(&cus, hipDeviceAttributeMultiprocessorCount, dev);
        hipFuncSetAttribute((const void*)mega, hipFuncAttributeMaxDynamicSharedMemorySize, LDS_BYTES);
        hipOccupancyMaxActiveBlocksPerMultiprocessor(&per_cu, (const void*)mega, 512, LDS_BYTES);
        (void)hipGetLastError();
        if (per_cu < 1) { fprintf(stderr, "kernel_launch: occupancy query says %d blocks/CU\n", per_cu); grid = -1; return; }
        grid = cus;
    }
    if (grid < 0) return;
    Params p; memset(&p, 0, sizeof(p));
    for (int i = 0; i < 19; ++i) p.in[i] = (const float*)d_in[i];
    p.out = (float*)d_out; p.ws = (unsigned char*)d_ws;
    unsigned char* ws = (unsigned char*)d_ws;
    int ns = 0, items = 0;
    auto add = [&](const float* src, const float* scale, size_t dst, int ld, int c0, int ncols, int K, int r0, int map, float cs) {
        Seg& s = p.seg[ns++]; s.src = src; s.scale = scale; s.dst = (bf16_t*)(ws + dst); s.ld = ld; s.c0 = c0; s.ncols = ncols; s.K = K; s.r0 = r0; s.map = map; s.item0 = items; s.cscale = cs;
        items += (K / 64) * ((ncols + 31) / 32);
    };
    const float* ab_w_in = p.in[1]; const float* cd_w_in = p.in[8];
    const float C8 = 0.125f * LOG2E, CMLA = 0.10206207261596577f * LOG2E;
    add(ab_w_in, nullptr, WS_WIN0, 1440, 0, 672, 1024, 0, 0, 1.f);
    add(ab_w_in, nullptr, WS_WIN0, 1440, 672, 512, 1024, 672, 0, C8);
    add(ab_w_in, nullptr, WS_WIN0, 1440, 1184, 256, 1024, 1184, 0, 1.f);
    add(nullptr, nullptr, WS_WIN0, 0, 0, 96, 1024, 1440, 0, 1.f);
    add(p.in[3], p.in[2], WS_WUQ, 768, 0, 768, 384, 0, 0, CMLA);
    add(p.in[5], p.in[4], WS_WUKV, 1024, 0, 1024, 256, 0, 0, 1.f);
    add(p.in[7], nullptr, WS_WOUT0, 1024, 0, 1024, 1024, 0, 0, 1.f);
    add(cd_w_in, nullptr, WS_WIN1, 3080, 0, 512, 1024, 0, 0, C8);
    add(cd_w_in, nullptr, WS_WIN1, 3080, 512, 1024, 1024, 512, 0, 1.f);
    add(cd_w_in, nullptr, WS_WIN1, 3080, 1544, 512, 1024, 1536, 0, C8);
    add(cd_w_in, nullptr, WS_WIN1, 3080, 2056, 1024, 1024, 2048, 0, 1.f);
    add(p.in[11], nullptr, WS_WOUT1, 1024, 0, 1024, 1024, 0, 0, 1.f);
    for (int l = 0; l < 2; ++l) {
        add(p.in[14] + (size_t)l * 1024 * DFF, nullptr, l ? WS_WGU1 : WS_WGU0, DFF, 0, DFF, 1024, 0, 1, 1.f);
        add(p.in[15] + (size_t)l * 1024 * DFF, nullptr, l ? WS_WGU1 : WS_WGU0, DFF, 0, DFF, 1024, 128, 1, 1.f);
        add(p.in[16] + (size_t)l * DFF * 1024, nullptr, l ? WS_WDN1 : WS_WDN0, 1024, 0, 1024, DFF, 0, 0, 1.f);
    }
    p.nseg = ns; p.nitems = items;
    if (hipMemsetAsync(ws + WS_CTL, 0, CTL_ZERO_BYTES, stream) != hipSuccess) { fprintf(stderr, "kernel_launch: memset failed\n"); return; }
#if ONE_LAUNCH
    p.lo = 0; p.hi = NPH;
    void* args[] = {&p};
    hipError_t e = hipLaunchCooperativeKernel((const void*)mega, dim3(grid), dim3(512), args, LDS_BYTES, stream);
    if (e != hipSuccess) fprintf(stderr, "cooperative launch failed: %s (grid %d)\n", hipGetErrorString(e), grid);
#else
    for (int ph = 0; ph < NPH; ++ph) { p.lo = ph; p.hi = ph + 1; hipLaunchKernelGGL(mega, dim3(grid), dim3(512), LDS_BYTES, stream, p); }
#endif
}
```
